# Optimizing an MI355X kernel written in HIP

```python
import math
import jax, jax.numpy as jnp
from jax import lax
import numpy as np

D_MODEL = 1024
BATCH = 4
SEQ = 4096
DEPTH = 1

SB_HEADS = 8
SB_HEAD_DIM = 64
SB_WIDTH = SB_HEADS * SB_HEAD_DIM
Q_BLOCK = 128
CONV_WIDTH = D_MODEL // 2
CONV_K = 3
MEM_LEN = 256
MEM_HEADS = 4
MEM_HEAD_DIM = D_MODEL // MEM_HEADS
FFN_HIDDEN = -(-8 * D_MODEL // (3 * 256)) * 256
EPS = 1e-6

IN_SPLITS = (SB_WIDTH, SB_WIDTH, SB_WIDTH, CONV_WIDTH, CONV_WIDTH, CONV_WIDTH, D_MODEL, D_MODEL)
IN_WIDTH = sum(IN_SPLITS)

kernel_name = "hybrid_stickbreak_shortconv_memxattn_swiglu"


def rms_norm(x, g):
    xf = x.astype(jnp.float32)
    var = jnp.mean(xf * xf, axis=-1, keepdims=True)
    return (xf * lax.rsqrt(var + EPS) * g.astype(jnp.float32)).astype(x.dtype)


def stick_breaking_attention(q, k, v):
    seq = q.shape[2]
    scale = 1.0 / math.sqrt(q.shape[-1])
    outs = []
    for blk in range(seq // Q_BLOCK):
        t0 = blk * Q_BLOCK
        n_keys = t0 + Q_BLOCK
        qb = q[:, :, t0:n_keys].astype(jnp.float32)
        kb = k[:, :, :n_keys].astype(jnp.float32)
        vb = v[:, :, :n_keys].astype(jnp.float32)
        z = jnp.einsum('bhqd,bhkd->bhqk', qb, kb) * scale
        q_pos = t0 + jnp.arange(Q_BLOCK)[:, None]
        k_pos = jnp.arange(n_keys)[None, :]
        mask = k_pos < q_pos
        log_fail = jnp.where(mask, jax.nn.log_sigmoid(-z), 0.0)
        log_later = lax.cumsum(log_fail, axis=3, reverse=True) - log_fail
        weights = jnp.where(mask, jnp.exp(jax.nn.log_sigmoid(z) + log_later), 0.0)
        outs.append(jnp.einsum('bhqk,bhkd->bhqd', weights, vb))
    return jnp.concatenate(outs, axis=2).astype(v.dtype)


def causal_depthwise_conv(u, w):
    c = u.shape[-1]
    return lax.conv_general_dilated(
        u, w[:, None, :].astype(u.dtype), window_strides=(1,), padding=((CONV_K - 1, 0),),
        dimension_numbers=('NWC', 'WIO', 'NWC'), feature_group_count=c)


def memory_cross_attention(h, m, w_q, w_kv, w_o):
    b, s, _ = h.shape
    mlen = m.shape[1]
    q = (h @ w_q).reshape(b, s, MEM_HEADS, MEM_HEAD_DIM)
    kv = (m @ w_kv).reshape(b, mlen, 2, MEM_HEADS, MEM_HEAD_DIM)
    k, v = kv[:, :, 0], kv[:, :, 1]
    scores = jnp.einsum('bshd,bmhd->bhsm', q.astype(jnp.float32), k.astype(jnp.float32))
    probs = jax.nn.softmax(scores / math.sqrt(MEM_HEAD_DIM), axis=-1)
    o = jnp.einsum('bhsm,bmhd->bshd', probs, v.astype(jnp.float32)).astype(h.dtype)
    return o.reshape(b, s, D_MODEL) @ w_o


def setup_inputs(seed: int = 0) -> dict:
    key = jax.random.key(seed)
    ks = jax.random.split(key, 20)
    f32 = jnp.float32

    def w(k, shape, fan_in):
        return jax.random.normal(k, shape, f32) * (fan_in ** -0.5)

    def gain(k, shape):
        return 1.0 + 0.05 * jax.random.normal(k, shape, f32)

    return {
        "x": jax.random.normal(ks[0], (BATCH, SEQ, D_MODEL), f32),
        "mem": jax.random.normal(ks[1], (BATCH, MEM_LEN, D_MODEL), f32),
        "norm_mix": gain(ks[2], (DEPTH, D_MODEL)),
        "w_in": w(ks[3], (DEPTH, D_MODEL, IN_WIDTH), D_MODEL),
        "conv_w": w(ks[4], (DEPTH, CONV_K, CONV_WIDTH), CONV_K),
        "w_branch_a": w(ks[5], (DEPTH, SB_WIDTH, D_MODEL), SB_WIDTH),
        "w_branch_b": w(ks[6], (DEPTH, CONV_WIDTH, D_MODEL), CONV_WIDTH),
        "w_mix_out": w(ks[7], (DEPTH, D_MODEL, D_MODEL), D_MODEL),
        "norm_mem_q": gain(ks[8], (DEPTH, D_MODEL)),
        "norm_mem_kv": gain(ks[9], (DEPTH, D_MODEL)),
        "w_mem_q": w(ks[10], (DEPTH, D_MODEL, D_MODEL), D_MODEL),
        "w_mem_kv": w(ks[11], (DEPTH, D_MODEL, 2 * D_MODEL), D_MODEL),
        "w_mem_o": w(ks[12], (DEPTH, D_MODEL, D_MODEL), D_MODEL),
        "norm_ffn": gain(ks[13], (DEPTH, D_MODEL)),
        "w_ffn_in": w(ks[14], (DEPTH, D_MODEL, 2 * FFN_HIDDEN), D_MODEL),
        "w_ffn_out": w(ks[15], (DEPTH, FFN_HIDDEN, D_MODEL), FFN_HIDDEN),
        "norm_final": gain(ks[16], (D_MODEL,)),
    }


def reference(x, mem, norm_mix, w_in, conv_w, w_branch_a, w_branch_b, w_mix_out,
              norm_mem_q, norm_mem_kv, w_mem_q, w_mem_kv, w_mem_o,
              norm_ffn, w_ffn_in, w_ffn_out, norm_final):
    b, s, _ = x.shape
    split_points = list(np.cumsum(IN_SPLITS)[:-1])
    for l in range(DEPTH):
        h = rms_norm(x, norm_mix[l])
        proj = h @ w_in[l]
        q_a, k_a, v_a, u_b, gate_b, gate_c, g_a, g_b = jnp.split(proj, split_points, axis=-1)

        def heads(t):
            return t.reshape(b, s, SB_HEADS, SB_HEAD_DIM).transpose(0, 2, 1, 3)

        o_a = stick_breaking_attention(heads(q_a), heads(k_a), heads(v_a))
        o_a = o_a.transpose(0, 2, 1, 3).reshape(b, s, SB_WIDTH)
        y_b = gate_b * causal_depthwise_conv(gate_c * u_b, conv_w[l])

        branch_a = o_a @ w_branch_a[l]
        branch_b = y_b @ w_branch_b[l]
        merged = jax.nn.sigmoid(g_a) * branch_a + jax.nn.sigmoid(g_b) * branch_b
        x = x + merged @ w_mix_out[l]

        x = x + memory_cross_attention(rms_norm(x, norm_mem_q[l]), rms_norm(mem, norm_mem_kv[l]),
                                       w_mem_q[l], w_mem_kv[l], w_mem_o[l])

        hf = rms_norm(x, norm_ffn[l])
        gate, up = jnp.split(hf @ w_ffn_in[l], 2, axis=-1)
        x = x + (jax.nn.silu(gate) * up) @ w_ffn_out[l]
    return rms_norm(x, norm_final)
```

```cpp
#include <hip/hip_runtime.h>
#include <cstdio>
#include <cstdint>

typedef unsigned short bf16;

constexpr int BATCH = 4, SEQ = 4096, D = 1024, M = BATCH * SEQ;
constexpr int SBH = 8, HD = 64, SBW = 512, CW = 512, INW = 5120;
constexpr int MEML = 256, MROWS = BATCH * MEML, MH = 4, MHD = 256;
constexpr int FF = 2816, FF2 = 2 * FF;
constexpr float EPS = 1e-6f;

constexpr size_t MiB = 1u << 20;
constexpr size_t WS_CTL = 0, CTL_ZERO_BYTES = 1 * MiB;
constexpr size_t WS_W1T = 1 * MiB;
constexpr size_t WS_WAT = 11 * MiB;
constexpr size_t WS_WBT = 12 * MiB;
constexpr size_t WS_WMT = 13 * MiB;
constexpr size_t WS_WQ2 = 15 * MiB;
constexpr size_t WS_WKVT = 17 * MiB;
constexpr size_t WS_WOT = 21 * MiB;
constexpr size_t WS_WF1T = 23 * MiB;
constexpr size_t WS_WF2T = 34 * MiB;
constexpr size_t WS_MEMB = 40 * MiB;
constexpr size_t WS_KC = 42 * MiB;
constexpr size_t WS_VC = 44 * MiB;
constexpr size_t WS_WQKT = 46 * MiB;
constexpr size_t WS_VWOT = 54 * MiB;
constexpr size_t WS_RS1 = 62 * MiB;
constexpr size_t WS_RS2 = 63 * MiB;
constexpr size_t WS_XB = 64 * MiB;
constexpr size_t WS_Q = 96 * MiB;
constexpr size_t WS_K = 112 * MiB;
constexpr size_t WS_VT = 128 * MiB;
constexpr size_t WS_CU = 144 * MiB;
constexpr size_t WS_GB = 160 * MiB;
constexpr size_t WS_SGA = 176 * MiB;
constexpr size_t WS_SGB = 208 * MiB;
constexpr size_t WS_RS3 = 240 * MiB;
constexpr size_t WS_SCR = 241 * MiB;
constexpr size_t WS_TMP = 112 * MiB;
constexpr size_t WS_MRG = 144 * MiB;
constexpr size_t WS_PB = 96 * MiB;
constexpr size_t WS_ACT = 96 * MiB;
constexpr size_t WS_END = 256 * MiB;

__host__ __device__ __forceinline__ unsigned f2bf(float f) { unsigned u = __builtin_bit_cast(unsigned, f); return (u + 0x7fffu + ((u >> 16) & 1u)) >> 16; }
__host__ __device__ __forceinline__ float bf2f(unsigned h) { return __builtin_bit_cast(float, (h & 0xffffu) << 16); }
__host__ __device__ __forceinline__ int p16(int i) { return 8 * ((i >> 2) & 1) + 4 * (i >> 3) + (i & 3); }
__host__ __device__ __forceinline__ int w1_src(int n) {
    const int pn = n >> 8, c = n & 255;
    if (pn < 6) return n;
    if (pn < 10) { const int i = pn - 6, bj = c >> 7, x = c & 127; return (bj == 0 ? 1536 : 2560) + 128 * i + x; }
    if (pn < 12) return 2048 + 256 * (pn - 10) + c;
    return 3072 + 256 * (pn - 12) + c;
}
__host__ __device__ __forceinline__ int wf1_src(int n) { const int pn = n >> 8, c = n & 255, bj = c >> 7, x = c & 127; return (bj == 0 ? 0 : FF) + 128 * pn + x; }

template <int MAP> __global__ void nv_wconv_t(const float* W, int K, int N, bf16* out, const float* gain, float scale) {
    const size_t idx = (size_t)blockIdx.x * blockDim.x + threadIdx.x; if (idx >= (size_t)K * N) return;
    const int n = (int)(idx / K), k = (int)(idx % K);
    const int src = MAP == 0 ? n : (MAP == 1 ? w1_src(n) : wf1_src(n));
    out[idx] = (bf16)f2bf(W[(size_t)k * N + src] * (gain ? gain[k] : 1.f) * scale);
}
__global__ void nv_wconv_n(const float* W, int K, int N, bf16* out, const float* gain, float scale) {
    const size_t idx = (size_t)blockIdx.x * blockDim.x + threadIdx.x; if (idx >= (size_t)K * N) return;
    const int k = (int)(idx / N);
    out[idx] = (bf16)f2bf(W[idx] * gain[k] * scale);
}
__device__ __forceinline__ float block_sum256(float v, float* red) {
    for (int o = 32; o > 0; o >>= 1) v += __shfl_xor(v, o);
    __syncthreads();
    if ((threadIdx.x & 63) == 0) red[threadIdx.x >> 6] = v;
    __syncthreads();
    return red[0] + red[1] + red[2] + red[3];
}
__global__ void __launch_bounds__(256) nv_rmsnorm_bf16(const float* x, const float* g, bf16* out) {
    __shared__ float red[4];
    const size_t row = blockIdx.x; const float4 v = ((const float4*)(x + row * D))[threadIdx.x];
    const float ss = block_sum256(v.x * v.x + v.y * v.y + v.z * v.z + v.w * v.w, red);
    const float rs = 1.0f / sqrtf(ss * (1.0f / D) + EPS);
    const float4 gg = ((const float4*)g)[threadIdx.x];
    bf16* o = out + row * D + threadIdx.x * 4;
    o[0] = (bf16)f2bf(v.x * rs * gg.x); o[1] = (bf16)f2bf(v.y * rs * gg.y); o[2] = (bf16)f2bf(v.z * rs * gg.z); o[3] = (bf16)f2bf(v.w * rs * gg.w);
}
__global__ void __launch_bounds__(256) nv_gemm(const bf16* A, int lda, const bf16* Bt, int ldb, float* C, int ldc, int K) {
    __shared__ float As[16][64], Bs[16][64];
    const int tx = threadIdx.x & 15, ty = threadIdx.x >> 4, row0 = blockIdx.y * 64, col0 = blockIdx.x * 64;
    const int lr = threadIdx.x >> 2, lk = (threadIdx.x & 3) * 4;
    float acc[4][4];
#pragma unroll
    for (int i = 0; i < 4; ++i)
#pragma unroll
        for (int j = 0; j < 4; ++j) acc[i][j] = 0.f;
    for (int k0 = 0; k0 < K; k0 += 16) {
        const uint2 av = *(const uint2*)(A + (size_t)(row0 + lr) * lda + k0 + lk);
        const uint2 bv = *(const uint2*)(Bt + (size_t)(col0 + lr) * ldb + k0 + lk);
        As[lk + 0][lr] = bf2f(av.x); As[lk + 1][lr] = bf2f(av.x >> 16); As[lk + 2][lr] = bf2f(av.y); As[lk + 3][lr] = bf2f(av.y >> 16);
        Bs[lk + 0][lr] = bf2f(bv.x); Bs[lk + 1][lr] = bf2f(bv.x >> 16); Bs[lk + 2][lr] = bf2f(bv.y); Bs[lk + 3][lr] = bf2f(bv.y >> 16);
        __syncthreads();
#pragma unroll
        for (int kk = 0; kk < 16; ++kk) {
            const float4 a = *(const float4*)&As[kk][ty * 4], b = *(const float4*)&Bs[kk][tx * 4];
            const float aa[4] = {a.x, a.y, a.z, a.w}, bb[4] = {b.x, b.y, b.z, b.w};
#pragma unroll
            for (int i = 0; i < 4; ++i)
#pragma unroll
                for (int j = 0; j < 4; ++j) acc[i][j] += aa[i] * bb[j];
        }
        __syncthreads();
    }
#pragma unroll
    for (int i = 0; i < 4; ++i) *(float4*)(C + (size_t)(row0 + ty * 4 + i) * ldc + col0 + tx * 4) = make_float4(acc[i][0], acc[i][1], acc[i][2], acc[i][3]);
}
__global__ void nv_epi1(const float* S, int t0, int rows, bf16* Q, bf16* Kb, bf16* VT, bf16* CU, bf16* GB, bf16* SGA, bf16* SGB) {
    const size_t idx = (size_t)blockIdx.x * blockDim.x + threadIdx.x; if (idx >= (size_t)rows * INW) return;
    const int r = (int)(idx / INW), n = (int)(idx % INW), t = t0 + r, pn = n >> 8, c = n & 255;
    const float v = S[idx];
    if (pn < 2) Q[(size_t)t * 512 + n] = (bf16)f2bf(v * 0.125f);
    else if (pn < 4) Kb[(size_t)t * 512 + (n - 512)] = (bf16)f2bf(v);
    else if (pn < 6) { const int col = n - 1024, h = col >> 6, d = col & 63, b = t / SEQ, s = t % SEQ;
        VT[((size_t)(b * SBH + h) * HD + d) * SEQ + (s & ~15) + p16(s & 15)] = (bf16)f2bf(v); }
    else if (pn < 10) { if (c < 128) { const float gc = S[idx + 128]; CU[(size_t)t * 512 + 128 * (pn - 6) + c] = (bf16)f2bf(v * gc); } }
    else if (pn < 12) GB[(size_t)t * 512 + (n - 2560)] = (bf16)f2bf(v);
    else if (pn < 16) SGA[(size_t)t * 1024 + (n - 3072)] = (bf16)f2bf(1.0f / (1.0f + expf(-v)));
    else SGB[(size_t)t * 1024 + (n - 4096)] = (bf16)f2bf(1.0f / (1.0f + expf(-v)));
}
__global__ void nv_epi_kv(const float* S, bf16* Kc, bf16* Vc) {
    const size_t idx = (size_t)blockIdx.x * blockDim.x + threadIdx.x; if (idx >= (size_t)MROWS * 2048) return;
    const int r = (int)(idx / 2048), n = (int)(idx % 2048);
    if (n < 1024) Kc[(size_t)r * 1024 + n] = (bf16)f2bf(S[idx]); else Vc[(size_t)r * 1024 + n - 1024] = (bf16)f2bf(S[idx]);
}
__global__ void __launch_bounds__(64) nv_sb_attn(const bf16* Q, const bf16* Kb, const bf16* VT, bf16* OA) {
    const int gid = blockIdx.x * 64 + threadIdx.x;
    const int s = gid % SEQ, bh = gid / SEQ, h = bh % SBH, b = bh / SBH;
    const size_t t = (size_t)b * SEQ + s;
    float q[64], o[64];
#pragma unroll
    for (int d = 0; d < 64; ++d) { q[d] = bf2f(Q[t * 512 + h * 64 + d]); o[d] = 0.f; }
    float carry = 0.f;
    const bf16* vt = VT + (size_t)bh * HD * SEQ;
    for (int k = s - 1; k >= 0; --k) {
        const bf16* kr = Kb + ((size_t)b * SEQ + k) * 512 + h * 64;
        float z = 0.f;
#pragma unroll
        for (int i = 0; i < 8; ++i) { const uint4 u = ((const uint4*)kr)[i];
            z += q[8 * i + 0] * bf2f(u.x) + q[8 * i + 1] * bf2f(u.x >> 16) + q[8 * i + 2] * bf2f(u.y) + q[8 * i + 3] * bf2f(u.y >> 16)
               + q[8 * i + 4] * bf2f(u.z) + q[8 * i + 5] * bf2f(u.z >> 16) + q[8 * i + 6] * bf2f(u.w) + q[8 * i + 7] * bf2f(u.w >> 16); }
        const float lf = -(fmaxf(z, 0.f) + log1pf(expf(-fabsf(z))));
        const float w = expf(z + lf + carry);
        carry += lf;
        const int kp = (k & ~15) + p16(k & 15);
#pragma unroll
        for (int d = 0; d < 64; ++d) o[d] += w * bf2f(vt[(size_t)d * SEQ + kp]);
    }
#pragma unroll
    for (int d = 0; d < 64; ++d) OA[t * 512 + h * 64 + d] = (bf16)f2bf(o[d]);
}
__global__ void nv_conv(const bf16* CU, const bf16* GB, const float* cw, bf16* YB) {
    const size_t idx = (size_t)blockIdx.x * blockDim.x + threadIdx.x; if (idx >= (size_t)M * CW) return;
    const int t = (int)(idx / CW), c = (int)(idx % CW), s = t % SEQ;
    float a = cw[2 * CW + c] * bf2f(CU[idx]);
    if (s >= 1) a += cw[1 * CW + c] * bf2f(CU[idx - CW]);
    if (s >= 2) a += cw[0 * CW + c] * bf2f(CU[idx - 2 * CW]);
    YB[idx] = (bf16)f2bf(bf2f(GB[idx]) * a);
}
__global__ void nv_epi3a(const float* S, int t0, int rows, const bf16* SGA, bf16* TMP) {
    const size_t idx = (size_t)blockIdx.x * blockDim.x + threadIdx.x; if (idx >= (size_t)rows * 1024) return;
    const size_t g = (size_t)t0 * 1024 + idx; TMP[g] = (bf16)f2bf(bf2f(SGA[g]) * S[idx]);
}
__global__ void nv_epi3b(const float* S, int t0, int rows, const bf16* SGB, const bf16* TMP, bf16* MRG) {
    const size_t idx = (size_t)blockIdx.x * blockDim.x + threadIdx.x; if (idx >= (size_t)rows * 1024) return;
    const size_t g = (size_t)t0 * 1024 + idx; MRG[g] = (bf16)f2bf(bf2f(TMP[g]) + bf2f(SGB[g]) * S[idx]);
}
__global__ void __launch_bounds__(256) nv_epi_res(const float* S, int t0, const float* base, float* xo, bf16* XB, float* RSP) {
    __shared__ float red[4];
    const size_t t = (size_t)t0 + blockIdx.x;
    const float4 a = ((const float4*)(S + (size_t)blockIdx.x * D))[threadIdx.x], bsv = ((const float4*)(base + t * D))[threadIdx.x];
    const float4 v = make_float4(a.x + bsv.x, a.y + bsv.y, a.z + bsv.z, a.w + bsv.w);
    ((float4*)(xo + t * D))[threadIdx.x] = v;
    if (XB) { bf16* o = XB + t * D + threadIdx.x * 4; o[0] = (bf16)f2bf(v.x); o[1] = (bf16)f2bf(v.y); o[2] = (bf16)f2bf(v.z); o[3] = (bf16)f2bf(v.w); }
    const float ss = block_sum256(v.x * v.x + v.y * v.y + v.z * v.z + v.w * v.w, red);
    if (threadIdx.x < 16) RSP[t * 16 + threadIdx.x] = threadIdx.x == 0 ? ss : 0.f;
}
__global__ void nv_store_bf16(const float* S, int rows, int cols, bf16* O, int ldo) {
    const size_t idx = (size_t)blockIdx.x * blockDim.x + threadIdx.x; if (idx >= (size_t)rows * cols) return;
    const int r = (int)(idx / cols), c = (int)(idx % cols); O[(size_t)r * ldo + c] = (bf16)f2bf(S[idx]);
}
__device__ __forceinline__ float rs_from_partials(const float* RSP, size_t t) {
    float s = 0.f;
#pragma unroll
    for (int i = 0; i < 16; ++i) s += RSP[t * 16 + i];
    return 1.0f / sqrtf(s * (1.0f / D) + EPS);
}
__global__ void nv_epi_softmax(const float* S, int t0, int rows, const float* RSP, bf16* PB) {
    const int idx = blockIdx.x * blockDim.x + threadIdx.x; if (idx >= rows * MH) return;
    const int r = idx / MH, h = idx % MH; const size_t t = (size_t)t0 + r;
    const float rs = rs_from_partials(RSP, t);
    const float* sp = S + (size_t)r * 1024 + h * 256;
    float mx = -INFINITY; for (int k = 0; k < 256; ++k) mx = fmaxf(mx, sp[k] * rs);
    float l = 0.f; for (int k = 0; k < 256; ++k) l += expf(sp[k] * rs - mx);
    const float il = 1.0f / l;
    for (int k = 0; k < 256; ++k) PB[t * 1024 + h * 256 + k] = (bf16)f2bf(expf(sp[k] * rs - mx) * il);
}
__global__ void nv_epi_swiglu(const float* S, int t0, int rows, const float* RSP, bf16* ACT) {
    const size_t idx = (size_t)blockIdx.x * blockDim.x + threadIdx.x; if (idx >= (size_t)rows * FF) return;
    const int r = (int)(idx / FF), j = (int)(idx % FF), pn = j >> 7, x = j & 127; const size_t t = (size_t)t0 + r;
    const float rs = rs_from_partials(RSP, t);
    const float g = S[(size_t)r * FF2 + 256 * pn + x] * rs, u = S[(size_t)r * FF2 + 256 * pn + 128 + x] * rs;
    ACT[t * FF + j] = (bf16)f2bf(g / (1.0f + expf(-g)) * u);
}
__global__ void __launch_bounds__(256) nv_final(float* xo, const float* RSP, const float* g) {
    const size_t t = blockIdx.x; const float rs = rs_from_partials(RSP, t);
    float4 v = ((float4*)(xo + t * D))[threadIdx.x]; const float4 gg = ((const float4*)g)[threadIdx.x];
    v.x *= rs * gg.x; v.y *= rs * gg.y; v.z *= rs * gg.z; v.w *= rs * gg.w;
    ((float4*)(xo + t * D))[threadIdx.x] = v;
}

static inline unsigned nblk(size_t n, int bs = 256) { return (unsigned)((n + bs - 1) / bs); }
extern "C" void kernel_launch(void* const* d_in, const int* in_sizes, int n_in, void* d_out, int out_size, void* d_ws, size_t ws_size, hipStream_t stream) {
    if (n_in != 17 || in_sizes[0] != M * D || out_size != M * D || ws_size < WS_END) { fprintf(stderr, "kernel_launch: unexpected shapes (n_in %d, in0 %d, out %d, ws %zu)\n", n_in, n_in > 0 ? in_sizes[0] : -1, out_size, ws_size); return; }
    const float* x = (const float*)d_in[0]; const float* mem = (const float*)d_in[1]; const float* norm_mix = (const float*)d_in[2]; const float* w_in = (const float*)d_in[3];
    const float* conv_w = (const float*)d_in[4]; const float* w_a = (const float*)d_in[5]; const float* w_b = (const float*)d_in[6]; const float* w_mix = (const float*)d_in[7];
    const float* norm_memq = (const float*)d_in[8]; const float* norm_memkv = (const float*)d_in[9]; const float* w_memq = (const float*)d_in[10]; const float* w_memkv = (const float*)d_in[11];
    const float* w_memo = (const float*)d_in[12]; const float* norm_ffn = (const float*)d_in[13]; const float* w_ffn_in = (const float*)d_in[14]; const float* w_ffn_out = (const float*)d_in[15];
    const float* norm_final = (const float*)d_in[16];
    unsigned char* ws = (unsigned char*)d_ws; float* out = (float*)d_out;
    bf16 *W1T = (bf16*)(ws + WS_W1T), *WAT = (bf16*)(ws + WS_WAT), *WBT = (bf16*)(ws + WS_WBT), *WMT = (bf16*)(ws + WS_WMT), *WQ2 = (bf16*)(ws + WS_WQ2), *WKVT = (bf16*)(ws + WS_WKVT),
         *WOT = (bf16*)(ws + WS_WOT), *WF1T = (bf16*)(ws + WS_WF1T), *WF2T = (bf16*)(ws + WS_WF2T), *MEMB = (bf16*)(ws + WS_MEMB), *KC = (bf16*)(ws + WS_KC), *VC = (bf16*)(ws + WS_VC),
         *WQKT = (bf16*)(ws + WS_WQKT), *VWOT = (bf16*)(ws + WS_VWOT), *XB = (bf16*)(ws + WS_XB), *Q = (bf16*)(ws + WS_Q), *KB = (bf16*)(ws + WS_K), *VT = (bf16*)(ws + WS_VT),
         *CU = (bf16*)(ws + WS_CU), *GB = (bf16*)(ws + WS_GB), *SGA = (bf16*)(ws + WS_SGA), *SGB = (bf16*)(ws + WS_SGB), *TMP = (bf16*)(ws + WS_TMP), *MRG = (bf16*)(ws + WS_MRG),
         *PB = (bf16*)(ws + WS_PB), *ACT = (bf16*)(ws + WS_ACT), *YB = (bf16*)(ws + WS_XB), *OA = Q;
    float *RS1 = (float*)(ws + WS_RS1), *RS2 = (float*)(ws + WS_RS2), *RS3 = (float*)(ws + WS_RS3), *SCR = (float*)(ws + WS_SCR);
    const int CH = 512;

    hipLaunchKernelGGL(nv_wconv_t<1>, dim3(nblk((size_t)INW * D)), dim3(256), 0, stream, w_in, D, INW, W1T, (const float*)nullptr, 1.0f);
    hipLaunchKernelGGL(nv_wconv_t<0>, dim3(nblk((size_t)D * SBW)), dim3(256), 0, stream, w_a, SBW, D, WAT, (const float*)nullptr, 1.0f);
    hipLaunchKernelGGL(nv_wconv_t<0>, dim3(nblk((size_t)D * CW)), dim3(256), 0, stream, w_b, CW, D, WBT, (const float*)nullptr, 1.0f);
    hipLaunchKernelGGL(nv_wconv_t<0>, dim3(nblk((size_t)D * D)), dim3(256), 0, stream, w_mix, D, D, WMT, (const float*)nullptr, 1.0f);
    hipLaunchKernelGGL(nv_wconv_n, dim3(nblk((size_t)D * D)), dim3(256), 0, stream, w_memq, D, D, WQ2, norm_memq, 1.0f / 16.0f);
    hipLaunchKernelGGL(nv_wconv_t<0>, dim3(nblk((size_t)D * 2048)), dim3(256), 0, stream, w_memkv, D, 2048, WKVT, (const float*)nullptr, 1.0f);
    hipLaunchKernelGGL(nv_wconv_t<0>, dim3(nblk((size_t)D * D)), dim3(256), 0, stream, w_memo, D, D, WOT, (const float*)nullptr, 1.0f);
    hipLaunchKernelGGL(nv_wconv_t<2>, dim3(nblk((size_t)D * FF2)), dim3(256), 0, stream, w_ffn_in, D, FF2, WF1T, norm_ffn, 1.0f);
    hipLaunchKernelGGL(nv_wconv_t<0>, dim3(nblk((size_t)FF * D)), dim3(256), 0, stream, w_ffn_out, FF, D, WF2T, (const float*)nullptr, 1.0f);
    hipLaunchKernelGGL(nv_rmsnorm_bf16, dim3(M), dim3(256), 0, stream, x, norm_mix, XB);
    hipLaunchKernelGGL(nv_rmsnorm_bf16, dim3(MROWS), dim3(256), 0, stream, mem, norm_memkv, MEMB);
    for (int t0 = 0; t0 < M; t0 += CH) {
        hipLaunchKernelGGL(nv_gemm, dim3(INW / 64, CH / 64), dim3(256), 0, stream, XB + (size_t)t0 * D, D, W1T, D, SCR, INW, D);
        hipLaunchKernelGGL(nv_epi1, dim3(nblk((size_t)CH * INW)), dim3(256), 0, stream, SCR, t0, CH, Q, KB, VT, CU, GB, SGA, SGB);
    }
    hipLaunchKernelGGL(nv_gemm, dim3(2048 / 64, MROWS / 64), dim3(256), 0, stream, MEMB, D, WKVT, D, SCR, 2048, D);
    hipLaunchKernelGGL(nv_epi_kv, dim3(nblk((size_t)MROWS * 2048)), dim3(256), 0, stream, SCR, KC, VC);
    hipLaunchKernelGGL(nv_sb_attn, dim3(BATCH * SBH * SEQ / 64), dim3(64), 0, stream, Q, KB, VT, OA);
    hipLaunchKernelGGL(nv_conv, dim3(nblk((size_t)M * CW)), dim3(256), 0, stream, CU, GB, conv_w, YB);
    for (int t0 = 0; t0 < M; t0 += CH) {
        hipLaunchKernelGGL(nv_gemm, dim3(D / 64, CH / 64), dim3(256), 0, stream, OA + (size_t)t0 * 512, 512, WAT, 512, SCR, D, 512);
        hipLaunchKernelGGL(nv_epi3a, dim3(nblk((size_t)CH * D)), dim3(256), 0, stream, SCR, t0, CH, SGA, TMP);
    }
    for (int t0 = 0; t0 < M; t0 += CH) {
        hipLaunchKernelGGL(nv_gemm, dim3(D / 64, CH / 64), dim3(256), 0, stream, YB + (size_t)t0 * 512, 512, WBT, 512, SCR, D, 512);
        hipLaunchKernelGGL(nv_epi3b, dim3(nblk((size_t)CH * D)), dim3(256), 0, stream, SCR, t0, CH, SGB, TMP, MRG);
    }
    for (int t0 = 0; t0 < M; t0 += CH) {
        hipLaunchKernelGGL(nv_gemm, dim3(D / 64, CH / 64), dim3(256), 0, stream, MRG + (size_t)t0 * D, D, WMT, D, SCR, D, D);
        hipLaunchKernelGGL(nv_epi_res, dim3(CH), dim3(256), 0, stream, SCR, t0, x, out, XB, RS1);
    }
    for (int b = 0; b < BATCH; ++b)
        for (int h = 0; h < MH; ++h) {
            hipLaunchKernelGGL(nv_gemm, dim3(D / 64, 256 / 64), dim3(256), 0, stream, KC + (size_t)(b * 256) * 1024 + h * 256, 1024, WQ2 + h * 256, 1024, SCR, D, 256);
            hipLaunchKernelGGL(nv_store_bf16, dim3(nblk((size_t)256 * D)), dim3(256), 0, stream, SCR, 256, D, WQKT + ((size_t)b * 1024 + h * 256) * 1024, 1024);
            hipLaunchKernelGGL(nv_gemm, dim3(256 / 64, D / 64), dim3(256), 0, stream, WOT + h * 256, 1024, VC + (size_t)(b * 256) * 1024 + h * 256, 1024, SCR, 256, 256);
            hipLaunchKernelGGL(nv_store_bf16, dim3(nblk((size_t)D * 256)), dim3(256), 0, stream, SCR, D, 256, VWOT + (size_t)b * 1024 * 1024 + h * 256, 1024);
        }
    for (int t0 = 0; t0 < M; t0 += CH) {
        const int b = t0 / SEQ;
        hipLaunchKernelGGL(nv_gemm, dim3(D / 64, CH / 64), dim3(256), 0, stream, XB + (size_t)t0 * D, D, WQKT + (size_t)b * 1024 * 1024, D, SCR, D, D);
        hipLaunchKernelGGL(nv_epi_softmax, dim3(nblk((size_t)CH * MH)), dim3(256), 0, stream, SCR, t0, CH, RS1, PB);
    }
    for (int t0 = 0; t0 < M; t0 += CH) {
        const int b = t0 / SEQ;
        hipLaunchKernelGGL(nv_gemm, dim3(D / 64, CH / 64), dim3(256), 0, stream, PB + (size_t)t0 * D, D, VWOT + (size_t)b * 1024 * 1024, D, SCR, D, D);
        hipLaunchKernelGGL(nv_epi_res, dim3(CH), dim3(256), 0, stream, SCR, t0, out, out, XB, RS2);
    }
    for (int t0 = 0; t0 < M; t0 += CH) {
        hipLaunchKernelGGL(nv_gemm, dim3(FF2 / 64, CH / 64), dim3(256), 0, stream, XB + (size_t)t0 * D, D, WF1T, D, SCR, FF2, D);
        hipLaunchKernelGGL(nv_epi_swiglu, dim3(nblk((size_t)CH * FF)), dim3(256), 0, stream, SCR, t0, CH, RS2, ACT);
    }
    for (int t0 = 0; t0 < M; t0 += CH) {
        hipLaunchKernelGGL(nv_gemm, dim3(D / 64, CH / 64), dim3(256), 0, stream, ACT + (size_t)t0 * FF, FF, WF2T, FF, SCR, D, FF);
        hipLaunchKernelGGL(nv_epi_res, dim3(CH), dim3(256), 0, stream, SCR, t0, out, out, (bf16*)nullptr, RS3);
    }
    hipLaunchKernelGGL(nv_final, dim3(M), dim3(256), 0, stream, out, RS3, norm_final);
}
```

```cpp
#include <hip/hip_runtime.h>
#include <cstdio>
#include <cstdint>

typedef unsigned short bf16;

constexpr int BATCH = 4, SEQ = 4096, D = 1024, M = BATCH * SEQ;
constexpr int SBH = 8, HD = 64, SBW = 512, CW = 512, INW = 5120;
constexpr int MEML = 256, MROWS = BATCH * MEML, MH = 4, MHD = 256;
constexpr int FF = 2816, FF2 = 2 * FF;
constexpr float EPS = 1e-6f;

constexpr size_t MiB = 1u << 20;
constexpr size_t WS_CTL = 0, CTL_ZERO_BYTES = 1 * MiB;
constexpr size_t WS_W1T = 1 * MiB;
constexpr size_t WS_WAT = 11 * MiB;
constexpr size_t WS_WBT = 12 * MiB;
constexpr size_t WS_WMT = 13 * MiB;
constexpr size_t WS_WQ2 = 15 * MiB;
constexpr size_t WS_WKVT = 17 * MiB;
constexpr size_t WS_WOT = 21 * MiB;
constexpr size_t WS_WF1T = 23 * MiB;
constexpr size_t WS_WF2T = 34 * MiB;
constexpr size_t WS_MEMB = 40 * MiB;
constexpr size_t WS_KC = 42 * MiB;
constexpr size_t WS_VC = 44 * MiB;
constexpr size_t WS_WQKT = 46 * MiB;
constexpr size_t WS_VWOT = 54 * MiB;
constexpr size_t WS_RS1 = 62 * MiB;
constexpr size_t WS_RS2 = 63 * MiB;
constexpr size_t WS_XB = 64 * MiB;
constexpr size_t WS_Q = 96 * MiB;
constexpr size_t WS_K = 112 * MiB;
constexpr size_t WS_VT = 128 * MiB;
constexpr size_t WS_CU = 144 * MiB;
constexpr size_t WS_GB = 160 * MiB;
constexpr size_t WS_SGA = 176 * MiB;
constexpr size_t WS_SGB = 208 * MiB;
constexpr size_t WS_RS3 = 240 * MiB;
constexpr size_t WS_SCR = 241 * MiB;
constexpr size_t WS_TMP = 112 * MiB;
constexpr size_t WS_MRG = 144 * MiB;
constexpr size_t WS_PB = 96 * MiB;
constexpr size_t WS_ACT = 96 * MiB;
constexpr size_t WS_END = 256 * MiB;

__host__ __device__ __forceinline__ unsigned f2bf(float f) { unsigned u = __builtin_bit_cast(unsigned, f); return (u + 0x7fffu + ((u >> 16) & 1u)) >> 16; }
__host__ __device__ __forceinline__ float bf2f(unsigned h) { return __builtin_bit_cast(float, (h & 0xffffu) << 16); }
__host__ __device__ __forceinline__ int p16(int i) { return 8 * ((i >> 2) & 1) + 4 * (i >> 3) + (i & 3); }
__host__ __device__ __forceinline__ int w1_src(int n) {
    const int pn = n >> 8, c = n & 255;
    if (pn < 6) return n;
    if (pn < 10) { const int i = pn - 6, bj = c >> 7, x = c & 127; return (bj == 0 ? 1536 : 2560) + 128 * i + x; }
    if (pn < 12) return 2048 + 256 * (pn - 10) + c;
    return 3072 + 256 * (pn - 12) + c;
}
__host__ __device__ __forceinline__ int wf1_src(int n) { const int pn = n >> 8, c = n & 255, bj = c >> 7, x = c & 127; return (bj == 0 ? 0 : FF) + 128 * pn + x; }

template <int MAP> __global__ void nv_wconv_t(const float* W, int K, int N, bf16* out, const float* gain, float scale) {
    const size_t idx = (size_t)blockIdx.x * blockDim.x + threadIdx.x; if (idx >= (size_t)K * N) return;
    const int n = (int)(idx / K), k = (int)(idx % K);
    const int src = MAP == 0 ? n : (MAP == 1 ? w1_src(n) : wf1_src(n));
    out[idx] = (bf16)f2bf(W[(size_t)k * N + src] * (gain ? gain[k] : 1.f) * scale);
}
__global__ void nv_wconv_n(const float* W, int K, int N, bf16* out, const float* gain, float scale) {
    const size_t idx = (size_t)blockIdx.x * blockDim.x + threadIdx.x; if (idx >= (size_t)K * N) return;
    const int k = (int)(idx / N);
    out[idx] = (bf16)f2bf(W[idx] * gain[k] * scale);
}
__device__ __forceinline__ float block_sum256(float v, float* red) {
    for (int o = 32; o > 0; o >>= 1) v += __shfl_xor(v, o);
    __syncthreads();
    if ((threadIdx.x & 63) == 0) red[threadIdx.x >> 6] = v;
    __syncthreads();
    return red[0] + red[1] + red[2] + red[3];
}
__global__ void __launch_bounds__(256) nv_rmsnorm_bf16(const float* x, const float* g, bf16* out) {
    __shared__ float red[4];
    const size_t row = blockIdx.x; const float4 v = ((const float4*)(x + row * D))[threadIdx.x];
    const float ss = block_sum256(v.x * v.x + v.y * v.y + v.z * v.z + v.w * v.w, red);
    const float rs = 1.0f / sqrtf(ss * (1.0f / D) + EPS);
    const float4 gg = ((const float4*)g)[threadIdx.x];
    bf16* o = out + row * D + threadIdx.x * 4;
    o[0] = (bf16)f2bf(v.x * rs * gg.x); o[1] = (bf16)f2bf(v.y * rs * gg.y); o[2] = (bf16)f2bf(v.z * rs * gg.z); o[3] = (bf16)f2bf(v.w * rs * gg.w);
}
__global__ void __launch_bounds__(256) nv_gemm(const bf16* A, int lda, const bf16* Bt, int ldb, float* C, int ldc, int K) {
    __shared__ float As[16][64], Bs[16][64];
    const int tx = threadIdx.x & 15, ty = threadIdx.x >> 4, row0 = blockIdx.y * 64, col0 = blockIdx.x * 64;
    const int lr = threadIdx.x >> 2, lk = (threadIdx.x & 3) * 4;
    float acc[4][4];
#pragma unroll
    for (int i = 0; i < 4; ++i)
#pragma unroll
        for (int j = 0; j < 4; ++j) acc[i][j] = 0.f;
    for (int k0 = 0; k0 < K; k0 += 16) {
        const uint2 av = *(const uint2*)(A + (size_t)(row0 + lr) * lda + k0 + lk);
        const uint2 bv = *(const uint2*)(Bt + (size_t)(col0 + lr) * ldb + k0 + lk);
        As[lk + 0][lr] = bf2f(av.x); As[lk + 1][lr] = bf2f(av.x >> 16); As[lk + 2][lr] = bf2f(av.y); As[lk + 3][lr] = bf2f(av.y >> 16);
        Bs[lk + 0][lr] = bf2f(bv.x); Bs[lk + 1][lr] = bf2f(bv.x >> 16); Bs[lk + 2][lr] = bf2f(bv.y); Bs[lk + 3][lr] = bf2f(bv.y >> 16);
        __syncthreads();
#pragma unroll
        for (int kk = 0; kk < 16; ++kk) {
            const float4 a = *(const float4*)&As[kk][ty * 4], b = *(const float4*)&Bs[kk][tx * 4];
            const float aa[4] = {a.x, a.y, a.z, a.w}, bb[4] = {b.x, b.y, b.z, b.w};
#pragma unroll
            for (int i = 0; i < 4; ++i)
#pragma unroll
                for (int j = 0; j < 4; ++j) acc[i][j] += aa[i] * bb[j];
        }
        __syncthreads();
    }
#pragma unroll
    for (int i = 0; i < 4; ++i) *(float4*)(C + (size_t)(row0 + ty * 4 + i) * ldc + col0 + tx * 4) = make_float4(acc[i][0], acc[i][1], acc[i][2], acc[i][3]);
}
__global__ void nv_epi1(const float* S, int t0, int rows, bf16* Q, bf16* Kb, bf16* VT, bf16* CU, bf16* GB, bf16* SGA, bf16* SGB) {
    const size_t idx = (size_t)blockIdx.x * blockDim.x + threadIdx.x; if (idx >= (size_t)rows * INW) return;
    const int r = (int)(idx / INW), n = (int)(idx % INW), t = t0 + r, pn = n >> 8, c = n & 255;
    const float v = S[idx];
    if (pn < 2) Q[(size_t)t * 512 + n] = (bf16)f2bf(v * 0.125f);
    else if (pn < 4) Kb[(size_t)t * 512 + (n - 512)] = (bf16)f2bf(v);
    else if (pn < 6) { const int col = n - 1024, h = col >> 6, d = col & 63, b = t / SEQ, s = t % SEQ;
        VT[((size_t)(b * SBH + h) * HD + d) * SEQ + (s & ~15) + p16(s & 15)] = (bf16)f2bf(v); }
    else if (pn < 10) { if (c < 128) { const float gc = S[idx + 128]; CU[(size_t)t * 512 + 128 * (pn - 6) + c] = (bf16)f2bf(v * gc); } }
    else if (pn < 12) GB[(size_t)t * 512 + (n - 2560)] = (bf16)f2bf(v);
    else if (pn < 16) SGA[(size_t)t * 1024 + (n - 3072)] = (bf16)f2bf(1.0f / (1.0f + expf(-v)));
    else SGB[(size_t)t * 1024 + (n - 4096)] = (bf16)f2bf(1.0f / (1.0f + expf(-v)));
}
__global__ void nv_epi_kv(const float* S, bf16* Kc, bf16* Vc) {
    const size_t idx = (size_t)blockIdx.x * blockDim.x + threadIdx.x; if (idx >= (size_t)MROWS * 2048) return;
    const int r = (int)(idx / 2048), n = (int)(idx % 2048);
    if (n < 1024) Kc[(size_t)r * 1024 + n] = (bf16)f2bf(S[idx]); else Vc[(size_t)r * 1024 + n - 1024] = (bf16)f2bf(S[idx]);
}
__global__ void __launch_bounds__(64) nv_sb_attn(const bf16* Q, const bf16* Kb, const bf16* VT, bf16* OA) {
    const int gid = blockIdx.x * 64 + threadIdx.x;
    const int s = gid % SEQ, bh = gid / SEQ, h = bh % SBH, b = bh / SBH;
    const size_t t = (size_t)b * SEQ + s;
    float q[64], o[64];
#pragma unroll
    for (int d = 0; d < 64; ++d) { q[d] = bf2f(Q[t * 512 + h * 64 + d]); o[d] = 0.f; }
    float carry = 0.f;
    const bf16* vt = VT + (size_t)bh * HD * SEQ;
    for (int k = s - 1; k >= 0; --k) {
        const bf16* kr = Kb + ((size_t)b * SEQ + k) * 512 + h * 64;
        float z = 0.f;
#pragma unroll
        for (int i = 0; i < 8; ++i) { const uint4 u = ((const uint4*)kr)[i];
            z += q[8 * i + 0] * bf2f(u.x) + q[8 * i + 1] * bf2f(u.x >> 16) + q[8 * i + 2] * bf2f(u.y) + q[8 * i + 3] * bf2f(u.y >> 16)
               + q[8 * i + 4] * bf2f(u.z) + q[8 * i + 5] * bf2f(u.z >> 16) + q[8 * i + 6] * bf2f(u.w) + q[8 * i + 7] * bf2f(u.w >> 16); }
        const float lf = -(fmaxf(z, 0.f) + log1pf(expf(-fabsf(z))));
        const float w = expf(z + lf + carry);
        carry += lf;
        const int kp = (k & ~15) + p16(k & 15);
#pragma unroll
        for (int d = 0; d < 64; ++d) o[d] += w * bf2f(vt[(size_t)d * SEQ + kp]);
    }
#pragma unroll
    for (int d = 0; d < 64; ++d) OA[t * 512 + h * 64 + d] = (bf16)f2bf(o[d]);
}
__global__ void nv_conv(const bf16* CU, const bf16* GB, const float* cw, bf16* YB) {
    const size_t idx = (size_t)blockIdx.x * blockDim.x + threadIdx.x; if (idx >= (size_t)M * CW) return;
    const int t = (int)(idx / CW), c = (int)(idx % CW), s = t % SEQ;
    float a = cw[2 * CW + c] * bf2f(CU[idx]);
    if (s >= 1) a += cw[1 * CW + c] * bf2f(CU[idx - CW]);
    if (s >= 2) a += cw[0 * CW + c] * bf2f(CU[idx - 2 * CW]);
    YB[idx] = (bf16)f2bf(bf2f(GB[idx]) * a);
}
__global__ void nv_epi3a(const float* S, int t0, int rows, const bf16* SGA, bf16* TMP) {
    const size_t idx = (size_t)blockIdx.x * blockDim.x + threadIdx.x; if (idx >= (size_t)rows * 1024) return;
    const size_t g = (size_t)t0 * 1024 + idx; TMP[g] = (bf16)f2bf(bf2f(SGA[g]) * S[idx]);
}
__global__ void nv_epi3b(const float* S, int t0, int rows, const bf16* SGB, const bf16* TMP, bf16* MRG) {
    const size_t idx = (size_t)blockIdx.x * blockDim.x + threadIdx.x; if (idx >= (size_t)rows * 1024) return;
    const size_t g = (size_t)t0 * 1024 + idx; MRG[g] = (bf16)f2bf(bf2f(TMP[g]) + bf2f(SGB[g]) * S[idx]);
}
__global__ void __launch_bounds__(256) nv_epi_res(const float* S, int t0, const float* base, float* xo, bf16* XB, float* RSP) {
    __shared__ float red[4];
    const size_t t = (size_t)t0 + blockIdx.x;
    const float4 a = ((const float4*)(S + (size_t)blockIdx.x * D))[threadIdx.x], bsv = ((const float4*)(base + t * D))[threadIdx.x];
    const float4 v = make_float4(a.x + bsv.x, a.y + bsv.y, a.z + bsv.z, a.w + bsv.w);
    ((float4*)(xo + t * D))[threadIdx.x] = v;
    if (XB) { bf16* o = XB + t * D + threadIdx.x * 4; o[0] = (bf16)f2bf(v.x); o[1] = (bf16)f2bf(v.y); o[2] = (bf16)f2bf(v.z); o[3] = (bf16)f2bf(v.w); }
    const float ss = block_sum256(v.x * v.x + v.y * v.y + v.z * v.z + v.w * v.w, red);
    if (threadIdx.x < 16) RSP[t * 16 + threadIdx.x] = threadIdx.x == 0 ? ss : 0.f;
}
__global__ void nv_store_bf16(const float* S, int rows, int cols, bf16* O, int ldo) {
    const size_t idx = (size_t)blockIdx.x * blockDim.x + threadIdx.x; if (idx >= (size_t)rows * cols) return;
    const int r = (int)(idx / cols), c = (int)(idx % cols); O[(size_t)r * ldo + c] = (bf16)f2bf(S[idx]);
}
__device__ __forceinline__ float rs_from_partials(const float* RSP, size_t t) {
    float s = 0.f;
#pragma unroll
    for (int i = 0; i < 16; ++i) s += RSP[t * 16 + i];
    return 1.0f / sqrtf(s * (1.0f / D) + EPS);
}
__global__ void nv_epi_softmax(const float* S, int t0, int rows, const float* RSP, bf16* PB) {
    const int idx = blockIdx.x * blockDim.x + threadIdx.x; if (idx >= rows * MH) return;
    const int r = idx / MH, h = idx % MH; const size_t t = (size_t)t0 + r;
    const float rs = rs_from_partials(RSP, t);
    const float* sp = S + (size_t)r * 1024 + h * 256;
    float mx = -INFINITY; for (int k = 0; k < 256; ++k) mx = fmaxf(mx, sp[k] * rs);
    float l = 0.f; for (int k = 0; k < 256; ++k) l += expf(sp[k] * rs - mx);
    const float il = 1.0f / l;
    for (int k = 0; k < 256; ++k) PB[t * 1024 + h * 256 + k] = (bf16)f2bf(expf(sp[k] * rs - mx) * il);
}
__global__ void nv_epi_swiglu(const float* S, int t0, int rows, const float* RSP, bf16* ACT) {
    const size_t idx = (size_t)blockIdx.x * blockDim.x + threadIdx.x; if (idx >= (size_t)rows * FF) return;
    const int r = (int)(idx / FF), j = (int)(idx % FF), pn = j >> 7, x = j & 127; const size_t t = (size_t)t0 + r;
    const float rs = rs_from_partials(RSP, t);
    const float g = S[(size_t)r * FF2 + 256 * pn + x] * rs, u = S[(size_t)r * FF2 + 256 * pn + 128 + x] * rs;
    ACT[t * FF + j] = (bf16)f2bf(g / (1.0f + expf(-g)) * u);
}
__global__ void __launch_bounds__(256) nv_final(float* xo, const float* RSP, const float* g) {
    const size_t t = blockIdx.x; const float rs = rs_from_partials(RSP, t);
    float4 v = ((float4*)(xo + t * D))[threadIdx.x]; const float4 gg = ((const float4*)g)[threadIdx.x];
    v.x *= rs * gg.x; v.y *= rs * gg.y; v.z *= rs * gg.z; v.w *= rs * gg.w;
    ((float4*)(xo + t * D))[threadIdx.x] = v;
}

namespace pg8 {
#define PG8_LAS __attribute__((address_space(3)))
typedef short bf16x8 __attribute__((ext_vector_type(8)));
typedef float f32x4 __attribute__((ext_vector_type(4)));
typedef unsigned u32x4 __attribute__((ext_vector_type(4)));
typedef unsigned u32x2 __attribute__((ext_vector_type(2)));
constexpr int BM = 256, BK = 64, HALF = 128, HTB = HALF * BK * 2  , STAGE_BYTES = 8 * HTB, NXCD = 8, WGM = 8;

__host__ __device__ __forceinline__ int lds_byte(int r, int c) { const int st = (r >> 4) * 2 + (c >> 5), rr = r & 15, cc = c & 31, ob = rr * 64 + cc * 2; return st * 1024 + (ob ^ (((ob >> 9) & 1) << 5)); }
__host__ __device__ __forceinline__ void stage_rc(int b, int& R, int& C) { const int st = b / 1024, sb = b % 1024, swz = sb ^ (((sb >> 9) & 1) << 5); R = (st >> 1) * 16 + swz / 64; C = (st & 1) * 32 + (swz % 64) / 2; }
__host__ __device__ __forceinline__ int perm32(int rho) { const int n = rho >> 4, i = rho & 15; return 8 * (i >> 2) + 4 * n + (i & 3); }

struct Unit { const char* a; const char* b; void* o; int nt, pm, pn, kind; };
__device__ __forceinline__ void tile_of(int L, int nM, int nN, int& pm, int& pn) {
    const int nwg = nM * nN; int wgid = L; { const int q = nwg / NXCD, r = nwg % NXCD, xcd = wgid % NXCD, off = wgid / NXCD; wgid = (xcd < r ? xcd * (q + 1) : r * (q + 1) + (xcd - r) * q) + off; }
    const int nig = WGM * nN, gid = wgid / nig, fm = gid * WGM, gsz = (nM - fm) < WGM ? (nM - fm) : WGM;
    pm = fm + ((wgid % nig) % gsz); pn = (wgid % nig) / gsz;
}

__device__ __forceinline__ unsigned cvt_pk_bf16(float lo, float hi) { unsigned r; asm volatile("v_cvt_pk_bf16_f32 %0, %1, %2" : "=v"(r) : "v"(lo), "v"(hi)); return r; }
__device__ __forceinline__ u32x4 pack8(const f32x4 v0, const f32x4 v1) { u32x4 w; w.x = cvt_pk_bf16(v0[0], v0[1]); w.y = cvt_pk_bf16(v0[2], v0[3]); w.z = cvt_pk_bf16(v1[0], v1[1]); w.w = cvt_pk_bf16(v1[2], v1[3]); return w; }
__device__ __forceinline__ void unpack8(const u32x4 w, f32x4& v0, f32x4& v1) {
    v0[0] = __builtin_bit_cast(float, w.x << 16); v0[1] = __builtin_bit_cast(float, w.x & 0xffff0000u); v0[2] = __builtin_bit_cast(float, w.y << 16); v0[3] = __builtin_bit_cast(float, w.y & 0xffff0000u);
    v1[0] = __builtin_bit_cast(float, w.z << 16); v1[1] = __builtin_bit_cast(float, w.z & 0xffff0000u); v1[2] = __builtin_bit_cast(float, w.w << 16); v1[3] = __builtin_bit_cast(float, w.w & 0xffff0000u);
}
__device__ __forceinline__ float fast_sigmoid(float v) { return __builtin_amdgcn_rcpf(1.0f + __builtin_amdgcn_exp2f(-1.4426950408889634f * v)); }
__device__ __forceinline__ float row_rs(const float* RSP, int row, int fq) {
    const f32x4 p = *(const f32x4*)(RSP + (size_t)row * 16 + 4 * fq); float s = (p[0] + p[1]) + (p[2] + p[3]);
    s += __shfl_xor(s, 16); s += __shfl_xor(s, 32);
    return 1.0f / sqrtf(s * (1.0f / 1024.0f) + 1e-6f);
}

__device__ __forceinline__ void store_bf16_tile(const f32x4 (&acc)[2][2][4][2], bf16* O, int ld, int row0, int col0, float sc) {
#pragma unroll
    for (int ai = 0; ai < 2; ++ai)
#pragma unroll
        for (int m = 0; m < 4; ++m) { bf16* rowp = O + (size_t)(row0 + ai * HALF + m * 16) * ld + col0;
#pragma unroll
            for (int bj = 0; bj < 2; ++bj) *(u32x4*)(rowp + bj * HALF) = pack8(acc[ai][bj][m][0] * sc, acc[ai][bj][m][1] * sc); }
}
struct Epi1 {
    static constexpr bool PERM = true, AFTER_DRAIN = false;
    bf16 *Q, *K, *VT, *CU, *GB, *SGA, *SGB, *KC, *VC;
    __device__ __forceinline__ void operator()(const f32x4 (&acc)[2][2][4][2], const Unit& u, int wr, int wc, int fr, int fq) const {
        const int row0 = u.pm * BM + wr * 64 + fr, cw = wc * 32 + 8 * fq, pn = u.pn;
        if (u.kind == 1) { store_bf16_tile(acc, pn < 4 ? KC : VC, 1024, row0, (pn & 3) * 256 + cw, 1.0f); return; }
        if (pn < 2) { store_bf16_tile(acc, Q, 512, row0, pn * 256 + cw, 0.125f); return; }
        if (pn < 4) { store_bf16_tile(acc, K, 512, row0, (pn - 2) * 256 + cw, 1.0f); return; }
        if (pn < 6) {
            const int pf = p16(fr);
#pragma unroll
            for (int ai = 0; ai < 2; ++ai)
#pragma unroll
                for (int m = 0; m < 4; ++m) { const int t16 = u.pm * BM + ai * HALF + wr * 64 + m * 16, b = t16 / SEQ, sl = (t16 % SEQ) + pf;
#pragma unroll
                    for (int bj = 0; bj < 2; ++bj)
#pragma unroll
                        for (int n = 0; n < 2; ++n)
#pragma unroll
                            for (int i = 0; i < 4; ++i) { const int col = 256 * (pn - 4) + 128 * bj + cw + 4 * n + i, h = col >> 6, d = col & 63;
                                VT[((size_t)(b * SBH + h) * HD + d) * SEQ + sl] = (bf16)f2bf(acc[ai][bj][m][n][i]); } }
            return; }
        if (pn < 10) {
#pragma unroll
            for (int ai = 0; ai < 2; ++ai)
#pragma unroll
                for (int m = 0; m < 4; ++m)
                    *(u32x4*)(CU + (size_t)(row0 + ai * HALF + m * 16) * 512 + 128 * (pn - 6) + cw) = pack8(acc[ai][0][m][0] * acc[ai][1][m][0], acc[ai][0][m][1] * acc[ai][1][m][1]);
            return; }
        if (pn < 12) { store_bf16_tile(acc, GB, 512, row0, (pn - 10) * 256 + cw, 1.0f); return; }
        bf16* SG = pn < 16 ? SGA : SGB; const int colt = ((pn - 12) & 3) * 256 + cw;
#pragma unroll
        for (int ai = 0; ai < 2; ++ai)
#pragma unroll
            for (int m = 0; m < 4; ++m)
#pragma unroll
                for (int bj = 0; bj < 2; ++bj) { f32x4 v0 = acc[ai][bj][m][0], v1 = acc[ai][bj][m][1];
#pragma unroll
                    for (int i = 0; i < 4; ++i) { v0[i] = fast_sigmoid(v0[i]); v1[i] = fast_sigmoid(v1[i]); }
                    *(u32x4*)(SG + (size_t)(row0 + ai * HALF + m * 16) * 1024 + colt + bj * HALF) = pack8(v0, v1); }
    }
};
struct Epi3 {
    static constexpr bool PERM = true, AFTER_DRAIN = false;
    const bf16 *SGA, *SGB; bf16 *TMP, *MRG;
    __device__ __forceinline__ void operator()(const f32x4 (&acc)[2][2][4][2], const Unit& u, int wr, int wc, int fr, int fq) const {
        const int row0 = u.pm * BM + wr * 64 + fr, col0 = u.pn * BM + wc * 32 + 8 * fq;
#pragma unroll
        for (int ai = 0; ai < 2; ++ai)
#pragma unroll
            for (int m = 0; m < 4; ++m)
#pragma unroll
                for (int bj = 0; bj < 2; ++bj) { const size_t off = (size_t)(row0 + ai * HALF + m * 16) * 1024 + col0 + bj * HALF; f32x4 g0, g1;
                    if (u.kind == 0) { unpack8(*(const u32x4*)(SGA + off), g0, g1); *(u32x4*)(TMP + off) = pack8(g0 * acc[ai][bj][m][0], g1 * acc[ai][bj][m][1]); }
                    else { f32x4 t0, t1; unpack8(*(const u32x4*)(SGB + off), g0, g1); unpack8(*(const u32x4*)(TMP + off), t0, t1); *(u32x4*)(MRG + off) = pack8(t0 + g0 * acc[ai][bj][m][0], t1 + g1 * acc[ai][bj][m][1]); } }
    }
};
struct EpiRes {
    static constexpr bool PERM = true, AFTER_DRAIN = false;
    const float* base; float* xo; bf16* XB; float* RSP;
    __device__ __forceinline__ void operator()(const f32x4 (&acc)[2][2][4][2], const Unit& u, int wr, int wc, int fr, int fq) const {
        if (u.kind != 0) { store_bf16_tile(acc, (bf16*)u.o, 1024, wr * 64 + fr, wc * 32 + 8 * fq, 1.0f); return; }
        const int row0 = u.pm * BM + wr * 64 + fr, col0 = u.pn * BM + wc * 32 + 8 * fq;
#pragma unroll
        for (int ai = 0; ai < 2; ++ai)
#pragma unroll
            for (int m = 0; m < 4; ++m) { const int row = row0 + ai * HALF + m * 16; float ss = 0.f;
#pragma unroll
                for (int bj = 0; bj < 2; ++bj) { const size_t off = (size_t)row * 1024 + col0 + bj * HALF;
                    const f32x4 v0 = *(const f32x4*)(base + off) + acc[ai][bj][m][0], v1 = *(const f32x4*)(base + off + 4) + acc[ai][bj][m][1];
                    *(f32x4*)(xo + off) = v0; *(f32x4*)(xo + off + 4) = v1;
                    if (XB) *(u32x4*)(XB + off) = pack8(v0, v1);
                    ss += (v0[0] * v0[0] + v0[1] * v0[1]) + (v0[2] * v0[2] + v0[3] * v0[3]) + (v1[0] * v1[0] + v1[1] * v1[1]) + (v1[2] * v1[2] + v1[3] * v1[3]); }
                ss += __shfl_xor(ss, 16); ss += __shfl_xor(ss, 32);
                if (fq == 0) RSP[(size_t)row * 16 + 4 * u.pn + wc] = ss; }
    }
};
struct Epi7 {
    static constexpr bool PERM = true, AFTER_DRAIN = false;
    const float* RSP; bf16* ACT;
    __device__ __forceinline__ void operator()(const f32x4 (&acc)[2][2][4][2], const Unit& u, int wr, int wc, int fr, int fq) const {
        const int row0 = u.pm * BM + wr * 64 + fr, col0 = u.pn * HALF + wc * 32 + 8 * fq;
#pragma unroll
        for (int ai = 0; ai < 2; ++ai)
#pragma unroll
            for (int m = 0; m < 4; ++m) { const int row = row0 + ai * HALF + m * 16; const float rs = row_rs(RSP, row, fq); f32x4 a0, a1;
#pragma unroll
                for (int i = 0; i < 4; ++i) { const float g0 = acc[ai][0][m][0][i] * rs, g1 = acc[ai][0][m][1][i] * rs;
                    a0[i] = g0 * fast_sigmoid(g0) * (acc[ai][1][m][0][i] * rs); a1[i] = g1 * fast_sigmoid(g1) * (acc[ai][1][m][1][i] * rs); }
                *(u32x4*)(ACT + (size_t)row * FF + col0) = pack8(a0, a1); }
    }
};
struct Epi5 {
    static constexpr bool PERM = true, AFTER_DRAIN = true;
    const float* RSP; bf16* PB;
    __device__ __forceinline__ void operator()(const f32x4 (&)[2][2][4][2], const Unit&, int, int, int, int) const {}
    __device__ __forceinline__ void fused(f32x4 (&acc)[2][2][4][2], const Unit& u, int wr, int wc, int fr, int fq, PG8_LAS unsigned char* lds, int wid, int lane) const {
        typedef float f32x2v __attribute__((ext_vector_type(2)));
        PG8_LAS f32x2v* PT = (PG8_LAS f32x2v*)lds;
        constexpr float L2E = 1.4426950408889634f;
        float mw[2][4];
#pragma unroll
        for (int ai = 0; ai < 2; ++ai)
#pragma unroll
            for (int m = 0; m < 4; ++m) { const int rl = ai * HALF + wr * 64 + m * 16 + fr; const float rs = row_rs(RSP, u.pm * BM + rl, fq) * L2E;
                float mx = -INFINITY;
#pragma unroll
                for (int bj = 0; bj < 2; ++bj)
#pragma unroll
                    for (int n = 0; n < 2; ++n)
#pragma unroll
                        for (int i = 0; i < 4; ++i) { const float s = acc[ai][bj][m][n][i] * rs; acc[ai][bj][m][n][i] = s; mx = fmaxf(mx, s); }
                mx = fmaxf(mx, __shfl_xor(mx, 16)); mx = fmaxf(mx, __shfl_xor(mx, 32));
                float l = 0.f;
#pragma unroll
                for (int bj = 0; bj < 2; ++bj)
#pragma unroll
                    for (int n = 0; n < 2; ++n)
#pragma unroll
                        for (int i = 0; i < 4; ++i) { const float e = __builtin_amdgcn_exp2f(acc[ai][bj][m][n][i] - mx); acc[ai][bj][m][n][i] = e; l += e; }
                l += __shfl_xor(l, 16); l += __shfl_xor(l, 32);
                mw[ai][m] = mx;
                if (fq == 0) PT[rl * 4 + wc] = (f32x2v){mx, l}; }
        asm volatile("s_waitcnt lgkmcnt(0)" ::: "memory"); __builtin_amdgcn_s_barrier(); asm volatile("" ::: "memory");
#pragma unroll
        for (int ai = 0; ai < 2; ++ai)
#pragma unroll
            for (int m = 0; m < 4; ++m) { const int rl = ai * HALF + wr * 64 + m * 16 + fr;
                const f32x2v a = PT[rl * 4 + 0], b = PT[rl * 4 + 1], c = PT[rl * 4 + 2], d = PT[rl * 4 + 3];
                const float mx = fmaxf(fmaxf(a.x, b.x), fmaxf(c.x, d.x));
                const float L = (a.y * __builtin_amdgcn_exp2f(a.x - mx) + b.y * __builtin_amdgcn_exp2f(b.x - mx)) + (c.y * __builtin_amdgcn_exp2f(c.x - mx) + d.y * __builtin_amdgcn_exp2f(d.x - mx));
                const float f = __builtin_amdgcn_exp2f(mw[ai][m] - mx) / L;
#pragma unroll
                for (int bj = 0; bj < 2; ++bj)
                    *(u32x4*)(PB + (size_t)(u.pm * BM + rl) * 1024 + u.pn * BM + bj * HALF + wc * 32 + 8 * fq) = pack8(acc[ai][bj][m][0] * f, acc[ai][bj][m][1] * f); }
    }
};

template <class Epi, class Sched, bool ALIGN_EPI = false, bool SP2 = false>
__device__ __forceinline__ void gemm_phase(PG8_LAS unsigned char* lds, const int lda, const int ldb, const Sched& S, const Epi& E) {
    const int tid = threadIdx.x, wid = __builtin_amdgcn_readfirstlane(tid >> 6), lane = tid & 63, wr = wid >> 2, wc = wid & 3, fr = lane & 15, fq = lane >> 4;
    unsigned voffA[2], voffB[2];
#pragma unroll
    for (int i = 0; i < 2; ++i) { int R, C; stage_rc(tid * 16 + i * 8192, R, C); const int Rb = Epi::PERM ? ((R & ~31) + perm32(R & 31)) : R;
        voffA[i] = (unsigned)(R * lda + C) * 2u; voffB[i] = (unsigned)(Rb * ldb + C) * 2u; }
    const size_t kstep = (size_t)(BK * 2);
    const size_t hstepA = (size_t)HALF * lda * 2, hstepB = (size_t)HALF * ldb * 2;
    const unsigned ldsw = (unsigned)wid * 1024u;
    const int aoff = lds_byte(wr * 64 + fr, fq * 8), boff = lds_byte(wc * 32 + fr, fq * 8);
#define PG8_SA(b, h) (((b) * 2 + (h)) * HTB)
#define PG8_SB(b, h) ((4 + (b) * 2 + (h)) * HTB)
#define PG8_STAGE(bufoff, gbase, voff) do { _Pragma("unroll") for (int _i = 0; _i < 2; ++_i) \
        __builtin_amdgcn_global_load_lds((const unsigned*)((const char*)(gbase) + (voff)[_i]), (PG8_LAS unsigned*)(lds + (bufoff) + ldsw + _i * 8192), 16, 0, 0); } while (0)
#define PG8_LDA(dst, b, h) do { _Pragma("unroll") for (int m = 0; m < 4; ++m) _Pragma("unroll") for (int k = 0; k < 2; ++k) dst[m][k] = *(const PG8_LAS bf16x8*)(lds + PG8_SA(b, h) + aoff + m * 2048 + k * 1024); } while (0)
#define PG8_LDB(dst, b, h) do { _Pragma("unroll") for (int n = 0; n < 2; ++n) _Pragma("unroll") for (int k = 0; k < 2; ++k) dst[n][k] = *(const PG8_LAS bf16x8*)(lds + PG8_SB(b, h) + boff + n * 2048 + k * 1024); } while (0)
#define PG8_MMA(ai, bj, At, Bt) do { __builtin_amdgcn_s_setprio(1); _Pragma("unroll") for (int m = 0; m < 4; ++m) _Pragma("unroll") for (int n = 0; n < 2; ++n) _Pragma("unroll") for (int k = 0; k < 2; ++k) \
        acc[ai][bj][m][n] = __builtin_amdgcn_mfma_f32_16x16x32_bf16(Bt[n][k], At[m][k], acc[ai][bj][m][n], 0, 0, 0); __builtin_amdgcn_s_setprio(0); } while (0)
#define PG8_WAIT_V(n) asm volatile("s_waitcnt vmcnt(" #n ")" ::: "memory")
#define PG8_WAIT_L(n) asm volatile("s_waitcnt lgkmcnt(" #n ")" ::: "memory")
#define PG8_BAR __builtin_amdgcn_s_barrier()
#define PG8_SCHED __builtin_amdgcn_sched_barrier(0)
    Unit cur, nxt; int ui = 0;
    if (!S.next(0, cur)) return;
    f32x4 acc[2][2][4][2];
#pragma unroll
    for (int a = 0; a < 2; ++a)
#pragma unroll
        for (int b = 0; b < 2; ++b)
#pragma unroll
            for (int m = 0; m < 4; ++m)
#pragma unroll
                for (int n = 0; n < 2; ++n) acc[a][b][m][n] = (f32x4){0.f, 0.f, 0.f, 0.f};
    bf16x8 At[4][2], B0[2][2], B1[2][2];
    const char* cA = cur.a; const char* cB = cur.b;
    if constexpr (SP2) {
        PG8_STAGE(PG8_SB(0, 0), cB, voffB); PG8_STAGE(PG8_SB(0, 1), cB + hstepB, voffB); PG8_STAGE(PG8_SA(0, 0), cA, voffA); PG8_STAGE(PG8_SA(0, 1), cA + hstepA, voffA);
        if (wr == 1) PG8_BAR;
        PG8_WAIT_V(2); PG8_BAR;
        PG8_STAGE(PG8_SB(1, 0), cB + kstep, voffB); PG8_STAGE(PG8_SA(1, 0), cA + kstep, voffA); PG8_STAGE(PG8_SB(1, 1), cB + hstepB + kstep, voffB);
        PG8_WAIT_V(6); PG8_BAR;
    } else {
        PG8_STAGE(PG8_SB(0, 0), cB, voffB); PG8_STAGE(PG8_SA(0, 0), cA, voffA); PG8_STAGE(PG8_SB(0, 1), cB + hstepB, voffB); PG8_STAGE(PG8_SA(0, 1), cA + hstepA, voffA);
        if (wr == 1) PG8_BAR;
        PG8_WAIT_V(4); PG8_BAR;
        PG8_STAGE(PG8_SB(1, 0), cB + kstep, voffB); PG8_STAGE(PG8_SA(1, 0), cA + kstep, voffA); PG8_STAGE(PG8_SB(1, 1), cB + hstepB + kstep, voffB);
        PG8_WAIT_V(6); PG8_BAR;
    }
    for (;;) {
        const bool has_next = S.next(ui + 1, nxt);
        const char* nA = has_next ? nxt.a : cA; const char* nB = has_next ? nxt.b : cB;
        const int nt = cur.nt;
        for (int t = 0; t < nt; t += 2) {
            const bool last = (t == nt - 2);
            const char* a1 = cA + (size_t)(t + 1) * kstep;
            const char* a2 = last ? nA : cA + (size_t)(t + 2) * kstep; const char* b2 = last ? nB : cB + (size_t)(t + 2) * kstep;
            const char* a3 = a2 + kstep; const char* b3 = b2 + kstep;
            if constexpr (SP2) {
            PG8_LDB(B0, 0, 0); PG8_LDB(B1, 0, 1); PG8_SCHED; PG8_LDA(At, 0, 0); PG8_STAGE(PG8_SA(1, 1), a1 + hstepA, voffA);
            PG8_WAIT_V(8); PG8_WAIT_L(0); PG8_BAR; PG8_MMA(0, 0, At, B0); PG8_MMA(0, 1, At, B1); PG8_BAR; PG8_SCHED;
            PG8_LDA(At, 0, 1); PG8_STAGE(PG8_SB(0, 0), b2, voffB); PG8_STAGE(PG8_SB(0, 1), b2 + hstepB, voffB); PG8_STAGE(PG8_SA(0, 0), a2, voffA);
            PG8_WAIT_V(8); PG8_WAIT_L(0); PG8_BAR; PG8_MMA(1, 0, At, B0); PG8_MMA(1, 1, At, B1); PG8_BAR; PG8_SCHED;
            PG8_LDB(B0, 1, 0); PG8_LDB(B1, 1, 1); PG8_SCHED; PG8_LDA(At, 1, 0); PG8_STAGE(PG8_SA(0, 1), a2 + hstepA, voffA);
            PG8_WAIT_V(8); PG8_WAIT_L(0); PG8_BAR; PG8_MMA(0, 0, At, B0); PG8_MMA(0, 1, At, B1); PG8_BAR; PG8_SCHED;
            PG8_LDA(At, 1, 1); PG8_STAGE(PG8_SB(1, 0), b3, voffB); PG8_STAGE(PG8_SB(1, 1), b3 + hstepB, voffB); PG8_STAGE(PG8_SA(1, 0), a3, voffA);
            PG8_WAIT_V(8); PG8_WAIT_L(0); PG8_BAR; PG8_MMA(1, 0, At, B0); PG8_MMA(1, 1, At, B1); PG8_BAR; PG8_SCHED;
            } else {
            PG8_LDB(B0, 0, 0); PG8_SCHED; PG8_LDA(At, 0, 0); PG8_STAGE(PG8_SA(1, 1), a1 + hstepA, voffA);
            PG8_WAIT_L(8); PG8_BAR; PG8_WAIT_L(0); PG8_MMA(0, 0, At, B0); PG8_BAR; PG8_SCHED;
            PG8_LDB(B1, 0, 1); PG8_STAGE(PG8_SB(0, 0), b2, voffB);
            PG8_BAR; PG8_WAIT_L(0); PG8_MMA(0, 1, At, B1); PG8_BAR;
            PG8_LDA(At, 0, 1); PG8_STAGE(PG8_SA(0, 0), a2, voffA);
            PG8_BAR; PG8_WAIT_L(0); PG8_MMA(1, 0, At, B0); PG8_BAR; PG8_SCHED;
            PG8_STAGE(PG8_SB(0, 1), b2 + hstepB, voffB);
            PG8_WAIT_V(6); PG8_BAR; PG8_MMA(1, 1, At, B1); PG8_BAR;
            PG8_LDB(B0, 1, 0); PG8_SCHED; PG8_LDA(At, 1, 0); PG8_STAGE(PG8_SA(0, 1), a2 + hstepA, voffA);
            PG8_WAIT_L(8); PG8_BAR; PG8_WAIT_L(0); PG8_MMA(0, 0, At, B0); PG8_BAR; PG8_SCHED;
            PG8_LDB(B1, 1, 1); PG8_STAGE(PG8_SB(1, 0), b3, voffB);
            PG8_BAR; PG8_WAIT_L(0); PG8_MMA(0, 1, At, B1); PG8_BAR;
            PG8_LDA(At, 1, 1); PG8_STAGE(PG8_SA(1, 0), a3, voffA);
            PG8_BAR; PG8_WAIT_L(0); PG8_MMA(1, 0, At, B0); PG8_BAR; PG8_SCHED;
            PG8_STAGE(PG8_SB(1, 1), b3 + hstepB, voffB);
            PG8_WAIT_V(6); PG8_BAR; PG8_MMA(1, 1, At, B1); PG8_BAR;
            }
        }
        if constexpr (ALIGN_EPI) { if (wr == 0) PG8_BAR; }
        if constexpr (!Epi::AFTER_DRAIN) { E(acc, cur, wr, wc, fr, fq); }
        if (!has_next) break;
#pragma unroll
        for (int a = 0; a < 2; ++a)
#pragma unroll
            for (int b = 0; b < 2; ++b)
#pragma unroll
                for (int m = 0; m < 4; ++m)
#pragma unroll
                    for (int n = 0; n < 2; ++n) acc[a][b][m][n] = (f32x4){0.f, 0.f, 0.f, 0.f};
        cur = nxt; cA = nA; cB = nB; ++ui;
        if constexpr (ALIGN_EPI) { if (wr == 1) PG8_BAR; }
    }
    PG8_WAIT_V(0);
    if constexpr (!ALIGN_EPI) { if (wr == 0) PG8_BAR; }
    PG8_BAR;
    if constexpr (Epi::AFTER_DRAIN) { E.fused(acc, cur, wr, wc, fr, fq, lds, wid, lane); }
#undef PG8_SA
#undef PG8_SB
#undef PG8_STAGE
#undef PG8_LDA
#undef PG8_LDB
#undef PG8_MMA
#undef PG8_WAIT_V
#undef PG8_WAIT_L
#undef PG8_BAR
#undef PG8_SCHED
}

struct SchedGrid {
    const char *A, *B; size_t a_tile, b_tile; int nM, nN, nt, G, c;
    __device__ __forceinline__ bool next(int i, Unit& u) const {
        const int L = i * G + c; if (L >= nM * nN) return false;
        tile_of(L, nM, nN, u.pm, u.pn); u.a = A + (size_t)u.pm * a_tile; u.b = B + (size_t)u.pn * b_tile; u.o = nullptr; u.nt = nt; u.kind = 0; return true;
    }
};
struct Sched1 {
    SchedGrid g; const char *MA, *MB;
    __device__ __forceinline__ bool next(int i, Unit& u) const {
        if (g.next(i, u)) return true;
        const int idx = i * g.G + g.c - g.nM * g.nN; if (idx >= 32) return false;
        u.pm = idx >> 3; u.pn = idx & 7; u.a = MA + (size_t)u.pm * 256 * 1024 * 2; u.b = MB + (size_t)u.pn * 256 * 1024 * 2; u.o = nullptr; u.nt = 16; u.kind = 1; return true;
    }
};
struct Sched3 {
    const char *OA, *YB, *WAT, *WBT; int G, c;
    __device__ __forceinline__ bool next(int i, Unit& u) const {
        if (i >= 2 || c >= 256) return false;
        tile_of(c, 64, 4, u.pm, u.pn); u.a = (i ? YB : OA) + (size_t)u.pm * 256 * 512 * 2; u.b = (i ? WBT : WAT) + (size_t)u.pn * 256 * 512 * 2; u.o = nullptr; u.nt = 8; u.kind = i; return true;
    }
};
struct Sched4 {
    SchedGrid g; const char *KC, *WQ2, *WOT, *VC; bf16 *WQKT, *VWOT;
    __device__ __forceinline__ bool next(int i, Unit& u) const {
        if (g.next(i, u)) return true;
        const int idx = i * g.G + g.c - 256; if (idx >= 128) return false;
        const int j = idx & 63, bb = j >> 4, h = (j >> 2) & 3, p = j & 3; u.pm = 0; u.pn = 0; u.nt = 4;
        if (idx < 64) { u.kind = 1; u.a = KC + ((size_t)(bb * 256) * 1024 + h * 256) * 2; u.b = WQ2 + ((size_t)(p * 256) * 1024 + h * 256) * 2; u.o = WQKT + ((size_t)(bb * 1024 + h * 256) * 1024 + p * 256); }
        else { u.kind = 2; u.a = WOT + ((size_t)(p * 256) * 1024 + h * 256) * 2; u.b = VC + ((size_t)(bb * 256) * 1024 + h * 256) * 2; u.o = VWOT + ((size_t)bb * 1024 * 1024 + (size_t)(p * 256) * 1024 + h * 256); }
        return true;
    }
};
struct SchedB {
    const char *A, *B; int G, c;
    __device__ __forceinline__ bool next(int i, Unit& u) const {
        const int L = i * G + c; if (L >= 256) return false;
        tile_of(L, 64, 4, u.pm, u.pn); u.a = A + (size_t)u.pm * 256 * 1024 * 2; u.b = B + (size_t)((u.pm >> 4) * 1024 + u.pn * 256) * 1024 * 2; u.o = nullptr; u.nt = 16; u.kind = 0; return true;
    }
};
}
namespace sba {
typedef short bf16x8 __attribute__((ext_vector_type(8)));
typedef float f32x16 __attribute__((ext_vector_type(16)));
typedef unsigned u32x4 __attribute__((ext_vector_type(4)));
typedef unsigned u32x2 __attribute__((ext_vector_type(2)));
__device__ __forceinline__ int crow(int r, int hi) { return (r & 3) + 8 * (r >> 2) + 4 * hi; }
__device__ __forceinline__ unsigned cvtpk(float lo, float hi) { unsigned r; asm volatile("v_cvt_pk_bf16_f32 %0, %1, %2" : "=v"(r) : "v"(lo), "v"(hi)); return r; }

template <bool MASK> __device__ __forceinline__ void tile_math(f32x16 (&p)[2], float& carry, const int q, const int k0, const int hi) {
    constexpr float L2E = 1.4426950408889634f, LN2 = 0.6931471805599453f;
    float lf[2][16], G[16];
#pragma unroll
    for (int kb = 0; kb < 2; ++kb)
#pragma unroll
        for (int r = 0; r < 16; ++r) { const float z = p[kb][r];
            const float sp = fmaxf(z, 0.f) + LN2 * __builtin_amdgcn_logf(1.0f + __builtin_amdgcn_exp2f(-L2E * fabsf(z)));
            float v = -sp;
            if (MASK) { const int key = k0 + 32 * kb + crow(r, hi); v = (key < q && key >= 0) ? v : 0.f; }
            lf[kb][r] = v; }
#pragma unroll
    for (int kb = 0; kb < 2; ++kb)
#pragma unroll
        for (int rq = 0; rq < 4; ++rq) { const float gs = (lf[kb][4 * rq] + lf[kb][4 * rq + 1]) + (lf[kb][4 * rq + 2] + lf[kb][4 * rq + 3]);
            const auto rr = __builtin_amdgcn_permlane32_swap(__float_as_uint(gs), __float_as_uint(gs), false, false);
            G[8 * kb + 2 * rq] = __uint_as_float(rr[0]); G[8 * kb + 2 * rq + 1] = __uint_as_float(rr[1]); }
    float Ec[16]; float a = carry;
#pragma unroll
    for (int g = 15; g >= 0; --g) { Ec[g] = a; a += G[g]; }
    carry = a;
#pragma unroll
    for (int kb = 0; kb < 2; ++kb)
#pragma unroll
        for (int rq = 0; rq < 4; ++rq) { float I = hi ? Ec[8 * kb + 2 * rq + 1] : Ec[8 * kb + 2 * rq];
#pragma unroll
            for (int i = 3; i >= 0; --i) { const int r = 4 * rq + i; I += lf[kb][r];
                float w = __builtin_amdgcn_exp2f(L2E * (p[kb][r] + I));
                if (MASK) { const int key = k0 + 32 * kb + crow(r, hi); w = (key < q && key >= 0) ? w : 0.f; }
                p[kb][r] = w; } }
}

__device__ __forceinline__ void sb_unit(const int bh, const int qblk, const bf16* Q, const bf16* K, const bf16* VT, bf16* OA, const int lane) {
    const int r32 = lane & 31, hi = lane >> 5, b = bh >> 3, h = bh & 7, q0 = qblk * 32;
    const size_t rowbase = (size_t)b * SEQ;
    bf16x8 qr[4];
    { const bf16* qp = Q + (rowbase + q0 + r32) * 512 + h * 64 + hi * 8;
#pragma unroll
      for (int d0 = 0; d0 < 4; ++d0) qr[d0] = *(const bf16x8*)(qp + 16 * d0); }
    f32x16 o[2]; o[0] = f32x16{}; o[1] = f32x16{};
    float carry = 0.f;
    const bf16* Kh = K + rowbase * 512 + h * 64 + hi * 8;
    const bf16* Vh = VT + (size_t)bh * HD * SEQ + (size_t)r32 * SEQ + 8 * hi;
    bf16x8 kf[2][4], kn[2][4];
#define SBA_LOADK(dst, kk0) do { _Pragma("unroll") for (int kb = 0; kb < 2; ++kb) { int key_ = (kk0) + 32 * kb + r32; key_ = key_ < 0 ? 0 : key_; const bf16* kp_ = Kh + (size_t)key_ * 512; \
        _Pragma("unroll") for (int d0 = 0; d0 < 4; ++d0) dst[kb][d0] = *(const bf16x8*)(kp_ + 16 * d0); } } while (0)
    int k0 = q0 + 32 - 64; bool first = true;
    SBA_LOADK(kf, k0);
    for (;;) {
        const bool more = k0 > 0;
        SBA_LOADK(kn, k0 - 64);
        bf16x8 vf[2][2][2];
#pragma unroll
        for (int kb = 0; kb < 2; ++kb)
#pragma unroll
            for (int s = 0; s < 2; ++s) { int kp = k0 + 32 * kb + 16 * s; kp = kp < 0 ? 0 : kp;
#pragma unroll
                for (int db = 0; db < 2; ++db) vf[kb][s][db] = *(const bf16x8*)(Vh + (size_t)(32 * db) * SEQ + kp); }
        f32x16 p[2]; p[0] = f32x16{}; p[1] = f32x16{};
#pragma unroll
        for (int kb = 0; kb < 2; ++kb)
#pragma unroll
            for (int d0 = 0; d0 < 4; ++d0) p[kb] = __builtin_amdgcn_mfma_f32_32x32x16_bf16(kf[kb][d0], qr[d0], p[kb], 0, 0, 0);
        if (first || k0 < 0) tile_math<true>(p, carry, q0 + r32, k0, hi); else tile_math<false>(p, carry, q0 + r32, k0, hi);
#pragma unroll
        for (int kb = 0; kb < 2; ++kb)
#pragma unroll
            for (int s = 0; s < 2; ++s) { u32x4 w; w.x = cvtpk(p[kb][8 * s + 0], p[kb][8 * s + 1]); w.y = cvtpk(p[kb][8 * s + 2], p[kb][8 * s + 3]); w.z = cvtpk(p[kb][8 * s + 4], p[kb][8 * s + 5]); w.w = cvtpk(p[kb][8 * s + 6], p[kb][8 * s + 7]);
                const bf16x8 wf = __builtin_bit_cast(bf16x8, w);
#pragma unroll
                for (int db = 0; db < 2; ++db) o[db] = __builtin_amdgcn_mfma_f32_32x32x16_bf16(vf[kb][s][db], wf, o[db], 0, 0, 0); }
        if (!more) break;
        if (__all(carry < -104.0f)) break;
#pragma unroll
        for (int kb = 0; kb < 2; ++kb)
#pragma unroll
            for (int d0 = 0; d0 < 4; ++d0) kf[kb][d0] = kn[kb][d0];
        k0 -= 64; first = false;
    }
#undef SBA_LOADK
    bf16* op = OA + (rowbase + q0 + r32) * 512 + h * 64 + 4 * hi;
#pragma unroll
    for (int db = 0; db < 2; ++db)
#pragma unroll
        for (int rq = 0; rq < 4; ++rq) { u32x2 w; w.x = cvtpk(o[db][4 * rq], o[db][4 * rq + 1]); w.y = cvtpk(o[db][4 * rq + 2], o[db][4 * rq + 3]);
            *(u32x2*)(op + 32 * db + 8 * rq) = w; }
}
__device__ __forceinline__ void conv_strip(const int t0, const bf16* CU, const bf16* GB, const float* cw, bf16* YB, const int lane) {
    typedef float f32x4 __attribute__((ext_vector_type(4)));
    const int c0 = 8 * lane, s0 = t0 % SEQ;
    f32x4 w[3][2];
#pragma unroll
    for (int i = 0; i < 3; ++i) { w[i][0] = *(const f32x4*)(cw + i * CW + c0); w[i][1] = *(const f32x4*)(cw + i * CW + c0 + 4); }
    f32x4 c2a, c2b, c1a, c1b;
    if (s0 >= 2) { pg8::unpack8(*(const u32x4*)(CU + (size_t)(t0 - 2) * CW + c0), c2a, c2b); pg8::unpack8(*(const u32x4*)(CU + (size_t)(t0 - 1) * CW + c0), c1a, c1b); }
    else { c2a = c2b = c1a = c1b = (f32x4){0.f, 0.f, 0.f, 0.f}; }
#pragma unroll
    for (int r = 0; r < 8; ++r) { const size_t off = (size_t)(t0 + r) * CW + c0; f32x4 ca, cb, ga, gb;
        pg8::unpack8(*(const u32x4*)(CU + off), ca, cb); pg8::unpack8(*(const u32x4*)(GB + off), ga, gb);
        const f32x4 ya = ga * ((w[2][0] * ca + w[1][0] * c1a) + w[0][0] * c2a), yb = gb * ((w[2][1] * cb + w[1][1] * c1b) + w[0][1] * c2b);
        *(u32x4*)(YB + off) = pg8::pack8(ya, yb);
        c2a = c1a; c2b = c1b; c1a = ca; c1b = cb; }
}
}
constexpr int NWAVES = 8;
constexpr int N_PHASES = 10;
constexpr int CW_BAR = 4096;
constexpr int RING_OFF = 0, RING_BYTES = 131072;
constexpr int LDSCTL_OFF = RING_BYTES, MISC_OFF = LDSCTL_OFF + 320;
constexpr int LDS_BYTES = 147456;

#define GAS __attribute__((address_space(1)))
#define LAS __attribute__((address_space(3)))
typedef unsigned v4u __attribute__((ext_vector_type(4)));
typedef unsigned v2u __attribute__((ext_vector_type(2)));
typedef float f32x4 __attribute__((ext_vector_type(4)));
#define LDS_WAIT() asm volatile("s_waitcnt lgkmcnt(0)" ::: "memory")
#define VM_WAIT() asm volatile("s_waitcnt vmcnt(0)" ::: "memory")
__device__ __forceinline__ unsigned pk2(float lo, float hi) { return f2bf(lo) | (f2bf(hi) << 16); }

#define XB_TMO      128
#define XB_XCNT(j)  (256  + 64 * (j))
#define XB_XSUB(j)  (1280 + 64 * (j))
#define XB_XGEN(j)  (2304 + 64 * (j))
#define XB_TOP      3328
#define XB_TOPGEN   3392
#define XCD_BAR_WORDS 3456
#define XB_SPIN_CAP (1u << 18)
__device__ __forceinline__ unsigned xb_ld(unsigned* p)              { return __hip_atomic_load(p, __ATOMIC_RELAXED, __HIP_MEMORY_SCOPE_AGENT); }
__device__ __forceinline__ unsigned xb_add(unsigned* p, unsigned v) { return __hip_atomic_fetch_add(p, v, __ATOMIC_RELAXED, __HIP_MEMORY_SCOPE_AGENT); }
__device__ __forceinline__ unsigned xb_xcc_id() { return (unsigned)__builtin_amdgcn_s_getreg((3 << 11) | 20) & 0xFu; }
#define XB_SPIN(cond, bar) do { unsigned _sp = 0; while (cond) { __builtin_amdgcn_s_sleep(1); \
    if ((++_sp & 255u) == 0u) { if (xb_ld(&(bar)[XB_TMO])) break; if (_sp > XB_SPIN_CAP) { atomicAdd(&(bar)[XB_TMO], 1u); break; } } } } while (0)
struct XcdBarrier { unsigned* bar; unsigned x; volatile LAS unsigned* st; };
__device__ __forceinline__ XcdBarrier xcd_barrier_post(unsigned* bar, volatile LAS unsigned* st) {
    XcdBarrier b; b.bar = bar; b.x = xb_xcc_id(); b.st = st;
    if (threadIdx.x == 0) (void)xb_add(&bar[XB_XCNT(b.x)], 1u);
    return b;
}
__device__ __forceinline__ void xcd_barrier_complete(unsigned* bar, unsigned x, unsigned& nloc, unsigned& nx) {
    const unsigned G = gridDim.x * gridDim.y * gridDim.z;
    unsigned sum, cnt, mine, sp = 0u;
    for (;;) {
        sum = 0u; cnt = 0u; mine = 0u;
#pragma unroll
        for (unsigned j = 0; j < 16; ++j) { const unsigned c = xb_ld(&bar[XB_XCNT(j)]); sum += c; cnt += (c > 0u) ? 1u : 0u; mine = (j == x) ? c : mine; }
        if (sum == G) break;
        __builtin_amdgcn_s_sleep(1);
        if ((++sp & 255u) == 0u) { if (xb_ld(&bar[XB_TMO])) break; if (sp > XB_SPIN_CAP) { atomicAdd(&bar[XB_TMO], 1u); break; } }
    }
    nloc = mine > 0u ? mine : 1u; nx = cnt > 0u ? cnt : 1u;
}
__device__ __forceinline__ void xcd_barrier(const XcdBarrier& b) {
    asm volatile("s_waitcnt vmcnt(0)" ::: "memory");
    __syncthreads();
    if (threadIdx.x == 0) {
        unsigned* bar = b.bar;
        __builtin_amdgcn_s_waitcnt(0);
        unsigned nloc = b.st[0], nx = b.st[1];
        if (nloc == 0u) { xcd_barrier_complete(bar, b.x, nloc, nx); b.st[0] = nloc; b.st[1] = nx; }
        const unsigned old = xb_add(&bar[XB_XSUB(b.x)], 1u);
        const unsigned gen = old / nloc;
        if (old + 1u == (gen + 1u) * nloc) {
            __builtin_amdgcn_fence(__ATOMIC_RELEASE, "agent");
            asm volatile("s_waitcnt vmcnt(0)" ::: "memory");
            const unsigned og = xb_add(&bar[XB_TOP], 1u);
            const unsigned tg = og / nx;
            if (og + 1u == (tg + 1u) * nx) xb_add(&bar[XB_TOPGEN], 1u);
            else XB_SPIN(xb_ld(&bar[XB_TOPGEN]) == tg, bar);
            __builtin_amdgcn_fence(__ATOMIC_ACQUIRE, "agent");
            xb_add(&bar[XB_XGEN(b.x)], 1u);
            asm volatile("s_waitcnt vmcnt(0)" ::: "memory");
        } else {
            XB_SPIN(xb_ld(&bar[XB_XGEN(b.x)]) == gen, bar);
            __builtin_amdgcn_fence(__ATOMIC_ACQUIRE, "agent");
            asm volatile("s_waitcnt vmcnt(0)" ::: "memory");
        }
    }
    __syncthreads();
}

__device__ __forceinline__ float wave_sum(float v) {
#pragma unroll
    for (int o = 1; o < 64; o <<= 1) v += __shfl_xor(v, o);
    return v;
}
__device__ __forceinline__ void p0_titem(const float* W, int N, int K, bf16* WT, int orow0, int scol0, int k0, const float* gain, LAS float* scr, int lane) {
#pragma unroll 8
    for (int i = 0; i < 32; ++i) { const int kk = 2 * i + (lane >> 5); float v = W[(size_t)(k0 + kk) * N + scol0 + (lane & 31)]; if (gain) v *= gain[k0 + kk]; scr[kk * 33 + (lane & 31)] = v; }
    LDS_WAIT(); asm volatile("" ::: "memory");
    const int c = lane & 7;
#pragma unroll
    for (int j = 0; j < 4; ++j) { const int n = (lane >> 3) + 8 * j; const LAS float* s = scr + (8 * c) * 33 + n;
        v4u o; o.x = pk2(s[0 * 33], s[1 * 33]); o.y = pk2(s[2 * 33], s[3 * 33]); o.z = pk2(s[4 * 33], s[5 * 33]); o.w = pk2(s[6 * 33], s[7 * 33]);
        *(GAS v4u*)(WT + (size_t)(orow0 + n) * K + k0 + 8 * c) = o; }
    LDS_WAIT(); asm volatile("" ::: "memory");
}
__device__ __forceinline__ void rms_row_to_bf16(const float* xrow, const float* g, bf16* orow, int lane) {
    const GAS f32x4* xr = (const GAS f32x4*)xrow + lane; const GAS f32x4* gr = (const GAS f32x4*)g + lane;
    f32x4 v[4]; float s = 0.f;
#pragma unroll
    for (int j = 0; j < 4; ++j) { v[j] = xr[64 * j]; s += (v[j].x * v[j].x + v[j].y * v[j].y) + (v[j].z * v[j].z + v[j].w * v[j].w); }
    const float rs = 1.0f / sqrtf(wave_sum(s) * (1.0f / D) + EPS);
    GAS unsigned long long* o8 = (GAS unsigned long long*)orow + lane;
#pragma unroll
    for (int j = 0; j < 4; ++j) { const f32x4 gg = gr[64 * j]; o8[64 * j] = (unsigned long long)pk2(v[j].x * rs * gg.x, v[j].y * rs * gg.y) | ((unsigned long long)pk2(v[j].z * rs * gg.z, v[j].w * rs * gg.w) << 32); }
}

struct Args { const float* in[17]; float* out; unsigned char* ws; int ph_lo, ph_hi, li, pad; };
__global__ void __launch_bounds__(NWAVES * 64, 2) mega_fwd(Args args) {
    extern __shared__ __attribute__((aligned(16))) unsigned char lds[];
    LAS unsigned char* const L = (LAS unsigned char*)lds;
    volatile LAS unsigned* const MISC = (volatile LAS unsigned*)(L + MISC_OFF);
    const int tid = threadIdx.x, lane = tid & 63, wave = __builtin_amdgcn_readfirstlane(tid >> 6);
    const int G = gridDim.x, bx = blockIdx.x, vcu = (G % 8 == 0) ? (bx % 8) * (G / 8) + bx / 8 : bx;
    const int gw = vcu * NWAVES + wave, NGW = G * NWAVES;
    unsigned char* const ws = args.ws;
    const float* x = args.in[0]; float* out = args.out;
    bf16 *W1T = (bf16*)(ws + WS_W1T), *WAT = (bf16*)(ws + WS_WAT), *WBT = (bf16*)(ws + WS_WBT), *WMT = (bf16*)(ws + WS_WMT), *WQ2 = (bf16*)(ws + WS_WQ2), *WKVT = (bf16*)(ws + WS_WKVT),
         *WOT = (bf16*)(ws + WS_WOT), *WF1T = (bf16*)(ws + WS_WF1T), *WF2T = (bf16*)(ws + WS_WF2T), *MEMB = (bf16*)(ws + WS_MEMB), *KC = (bf16*)(ws + WS_KC), *VC = (bf16*)(ws + WS_VC),
         *WQKT = (bf16*)(ws + WS_WQKT), *VWOT = (bf16*)(ws + WS_VWOT), *XB = (bf16*)(ws + WS_XB), *Q = (bf16*)(ws + WS_Q), *KB = (bf16*)(ws + WS_K), *VT = (bf16*)(ws + WS_VT),
         *CU = (bf16*)(ws + WS_CU), *GB = (bf16*)(ws + WS_GB), *SGA = (bf16*)(ws + WS_SGA), *SGB = (bf16*)(ws + WS_SGB), *TMP = (bf16*)(ws + WS_TMP), *MRG = (bf16*)(ws + WS_MRG),
         *PB = (bf16*)(ws + WS_PB), *ACT = (bf16*)(ws + WS_ACT), *YB = (bf16*)(ws + WS_XB), *OA = Q;
    float *RS1 = (float*)(ws + WS_RS1), *RS2 = (float*)(ws + WS_RS2), *RS3 = (float*)(ws + WS_RS3);

    for (int u = tid; u < (LDS_BYTES - LDSCTL_OFF) / 4; u += NWAVES * 64) ((LAS unsigned*)(L + LDSCTL_OFF))[u] = 0u;
    __syncthreads();
    const int lo = args.ph_lo, hi = args.ph_hi;
    XcdBarrier bar; bar.bar = (unsigned*)(ws + WS_CTL) + CW_BAR + args.li * XCD_BAR_WORDS; bar.x = 0; bar.st = nullptr;
    if (hi - lo > 1) bar = xcd_barrier_post((unsigned*)(ws + WS_CTL) + CW_BAR + args.li * XCD_BAR_WORDS, MISC + 8);
#define IN(k) (lo <= (k) && (k) < hi)
#define SEAM(k) do { if (IN(k) && IN((k) + 1)) xcd_barrier(bar); } while (0)

    if (IN(0)) {
        LAS float* scr = (LAS float*)(L + RING_OFF + wave * 16384);
        const float *w_in = args.in[3], *w_a = args.in[5], *w_b = args.in[6], *w_mix = args.in[7], *w_memq = args.in[10], *w_memkv = args.in[11], *w_memo = args.in[12], *w_f1 = args.in[14], *w_f2 = args.in[15];
        constexpr int I_1 = (D / 64) * (INW / 32), I_A = (SBW / 64) * (D / 32), I_M = (D / 64) * (D / 32), I_KV = (D / 64) * (2048 / 32), I_F1 = (D / 64) * (FF2 / 32), I_F2 = (FF / 64) * (D / 32);
        constexpr int NITEMS = I_1 + 2 * I_A + I_M + I_KV + I_M + I_F1 + I_F2;
        for (int it = gw; it < NITEMS; it += NGW) {
            int r = it;
            if (r < I_1) { const int nb = r % (INW / 32), kb = r / (INW / 32); p0_titem(w_in, INW, D, W1T, 32 * nb, w1_src(32 * nb), 64 * kb, nullptr, scr, lane); continue; } r -= I_1;
            if (r < I_A) { const int nb = r % (D / 32), kb = r / (D / 32); p0_titem(w_a, D, SBW, WAT, 32 * nb, 32 * nb, 64 * kb, nullptr, scr, lane); continue; } r -= I_A;
            if (r < I_A) { const int nb = r % (D / 32), kb = r / (D / 32); p0_titem(w_b, D, CW, WBT, 32 * nb, 32 * nb, 64 * kb, nullptr, scr, lane); continue; } r -= I_A;
            if (r < I_M) { const int nb = r % (D / 32), kb = r / (D / 32); p0_titem(w_mix, D, D, WMT, 32 * nb, 32 * nb, 64 * kb, nullptr, scr, lane); continue; } r -= I_M;
            if (r < I_KV) { const int nb = r % (2048 / 32), kb = r / (2048 / 32); p0_titem(w_memkv, 2048, D, WKVT, 32 * nb, 32 * nb, 64 * kb, nullptr, scr, lane); continue; } r -= I_KV;
            if (r < I_M) { const int nb = r % (D / 32), kb = r / (D / 32); p0_titem(w_memo, D, D, WOT, 32 * nb, 32 * nb, 64 * kb, nullptr, scr, lane); continue; } r -= I_M;
            if (r < I_F1) { const int nb = r % (FF2 / 32), kb = r / (FF2 / 32); p0_titem(w_f1, FF2, D, WF1T, 32 * nb, wf1_src(32 * nb), 64 * kb, args.in[13], scr, lane); continue; } r -= I_F1;
            { const int nb = r % (D / 32), kb = r / (D / 32); p0_titem(w_f2, D, FF, WF2T, 32 * nb, 32 * nb, 64 * kb, nullptr, scr, lane); }
        }
        for (int k = gw; k < D; k += NGW) {
            const float gk = args.in[8][k] * (1.0f / 16.0f);
#pragma unroll
            for (int j = 0; j < 4; ++j) { const f32x4 v = *((const GAS f32x4*)(w_memq + (size_t)k * D) + lane + 64 * j);
                *((GAS v2u*)(WQ2 + (size_t)k * D) + lane + 64 * j) = (v2u){pk2(v.x * gk, v.y * gk), pk2(v.z * gk, v.w * gk)}; }
        }
        for (int m = gw; m < M; m += NGW) rms_row_to_bf16(x + (size_t)m * D, args.in[2], XB + (size_t)m * D, lane);
        for (int m = gw; m < MROWS; m += NGW) rms_row_to_bf16(args.in[1] + (size_t)m * D, args.in[9], MEMB + (size_t)m * D, lane);
    }
    SEAM(0);
    if (IN(1)) {
        pg8::Sched1 S; S.g = pg8::SchedGrid{(const char*)XB, (const char*)W1T, (size_t)256 * D * 2, (size_t)256 * D * 2, 64, INW / 256, D / 64, G, bx}; S.MA = (const char*)MEMB; S.MB = (const char*)WKVT;
        pg8::Epi1 E{Q, KB, VT, CU, GB, SGA, SGB, KC, VC};
        pg8::gemm_phase<pg8::Epi1, pg8::Sched1, true, true>(L + RING_OFF, D, D, S, E);
    }
    SEAM(1);
    if (IN(2)) {
        for (int wu = gw; wu < BATCH * SBH * (SEQ / 32); wu += NGW) sba::sb_unit(wu >> 7, wu & 127, Q, KB, VT, OA, lane);
        for (int st = gw; st < M / 8; st += NGW) sba::conv_strip(8 * st, CU, GB, args.in[4], YB, lane);
    }
    SEAM(2);
    if (IN(3)) {
        pg8::Sched3 S{(const char*)OA, (const char*)YB, (const char*)WAT, (const char*)WBT, G, bx};
        pg8::Epi3 E{SGA, SGB, TMP, MRG};
        pg8::gemm_phase<pg8::Epi3, pg8::Sched3, true, true>(L + RING_OFF, 512, 512, S, E);
    }
    SEAM(3);
    if (IN(4)) {
        pg8::Sched4 S; S.g = pg8::SchedGrid{(const char*)MRG, (const char*)WMT, (size_t)256 * D * 2, (size_t)256 * D * 2, 64, 4, D / 64, G, bx};
        S.KC = (const char*)KC; S.WQ2 = (const char*)WQ2; S.WOT = (const char*)WOT; S.VC = (const char*)VC; S.WQKT = WQKT; S.VWOT = VWOT;
        pg8::EpiRes E{x, out, XB, RS1};
        pg8::gemm_phase<pg8::EpiRes, pg8::Sched4, true, true>(L + RING_OFF, D, D, S, E);
    }
    SEAM(4);
    if (IN(5)) {
        pg8::SchedB S{(const char*)XB, (const char*)WQKT, G, bx};
        pg8::Epi5 E{RS1, PB};
        pg8::gemm_phase<pg8::Epi5, pg8::SchedB, false, true>(L + RING_OFF, D, D, S, E);
    }
    SEAM(5);
    if (IN(6)) {
        pg8::SchedB S{(const char*)PB, (const char*)VWOT, G, bx};
        pg8::EpiRes E{out, out, XB, RS2};
        pg8::gemm_phase<pg8::EpiRes, pg8::SchedB, true, true>(L + RING_OFF, D, D, S, E);
    }
    SEAM(6);
    if (IN(7)) {
        pg8::SchedGrid S{(const char*)XB, (const char*)WF1T, (size_t)256 * D * 2, (size_t)256 * D * 2, 64, FF2 / 256, D / 64, G, bx};
        pg8::Epi7 E{RS2, ACT};
        pg8::gemm_phase<pg8::Epi7, pg8::SchedGrid, true, true>(L + RING_OFF, D, D, S, E);
    }
    SEAM(7);
    if (IN(8)) {
        pg8::SchedGrid S{(const char*)ACT, (const char*)WF2T, (size_t)256 * FF * 2, (size_t)256 * FF * 2, 64, 4, FF / 64, G, bx};
        pg8::EpiRes E{out, out, (bf16*)nullptr, RS3};
        pg8::gemm_phase<pg8::EpiRes, pg8::SchedGrid, true, true>(L + RING_OFF, FF, FF, S, E);
    }
    SEAM(8);
    if (IN(9)) {
        const float* gf = args.in[16];
        for (int m = gw; m < M; m += NGW) {
            float s = lane < 16 ? RS3[(size_t)m * 16 + lane] : 0.f; s = wave_sum(s);
            const float rs = 1.0f / sqrtf(s * (1.0f / D) + EPS);
            GAS f32x4* o = (GAS f32x4*)(out + (size_t)m * D) + lane; const GAS f32x4* gr = (const GAS f32x4*)gf + lane;
#pragma unroll
            for (int j = 0; j < 4; ++j) { f32x4 v = o[64 * j]; const f32x4 gg = gr[64 * j]; v = v * gg * rs; o[64 * j] = v; }
        }
    }
#undef IN
#undef SEAM
}
#ifndef MEGA_MASK
#define MEGA_MASK 0x3ff
#endif
static inline unsigned nblk(size_t n, int bs = 256) { return (unsigned)((n + bs - 1) / bs); }
static void naive_phase(int ph, void* const* d_in, void* d_out, void* d_ws, hipStream_t stream) {
    const float* x = (const float*)d_in[0]; const float* mem = (const float*)d_in[1]; const float* norm_mix = (const float*)d_in[2]; const float* w_in = (const float*)d_in[3];
    const float* conv_w = (const float*)d_in[4]; const float* w_a = (const float*)d_in[5]; const float* w_b = (const float*)d_in[6]; const float* w_mix = (const float*)d_in[7];
    const float* norm_memq = (const float*)d_in[8]; const float* norm_memkv = (const float*)d_in[9]; const float* w_memq = (const float*)d_in[10]; const float* w_memkv = (const float*)d_in[11];
    const float* w_memo = (const float*)d_in[12]; const float* norm_ffn = (const float*)d_in[13]; const float* w_ffn_in = (const float*)d_in[14]; const float* w_ffn_out = (const float*)d_in[15];
    const float* norm_final = (const float*)d_in[16];
    unsigned char* ws = (unsigned char*)d_ws; float* out = (float*)d_out;
    bf16 *W1T = (bf16*)(ws + WS_W1T), *WAT = (bf16*)(ws + WS_WAT), *WBT = (bf16*)(ws + WS_WBT), *WMT = (bf16*)(ws + WS_WMT), *WQ2 = (bf16*)(ws + WS_WQ2), *WKVT = (bf16*)(ws + WS_WKVT),
         *WOT = (bf16*)(ws + WS_WOT), *WF1T = (bf16*)(ws + WS_WF1T), *WF2T = (bf16*)(ws + WS_WF2T), *MEMB = (bf16*)(ws + WS_MEMB), *KC = (bf16*)(ws + WS_KC), *VC = (bf16*)(ws + WS_VC),
         *WQKT = (bf16*)(ws + WS_WQKT), *VWOT = (bf16*)(ws + WS_VWOT), *XB = (bf16*)(ws + WS_XB), *Q = (bf16*)(ws + WS_Q), *KB = (bf16*)(ws + WS_K), *VT = (bf16*)(ws + WS_VT),
         *CU = (bf16*)(ws + WS_CU), *GB = (bf16*)(ws + WS_GB), *SGA = (bf16*)(ws + WS_SGA), *SGB = (bf16*)(ws + WS_SGB), *TMP = (bf16*)(ws + WS_TMP), *MRG = (bf16*)(ws + WS_MRG),
         *PB = (bf16*)(ws + WS_PB), *ACT = (bf16*)(ws + WS_ACT), *YB = (bf16*)(ws + WS_XB), *OA = Q;
    float *RS1 = (float*)(ws + WS_RS1), *RS2 = (float*)(ws + WS_RS2), *RS3 = (float*)(ws + WS_RS3), *SCR = (float*)(ws + WS_SCR);
    const int CH = 512;
    (void)x; (void)mem; (void)norm_mix; (void)w_in; (void)conv_w; (void)w_a; (void)w_b; (void)w_mix; (void)norm_memq; (void)norm_memkv; (void)w_memq; (void)w_memkv; (void)w_memo; (void)norm_ffn; (void)w_ffn_in; (void)w_ffn_out; (void)norm_final;
    (void)W1T; (void)WAT; (void)WBT; (void)WMT; (void)WQ2; (void)WKVT; (void)WOT; (void)WF1T; (void)WF2T; (void)MEMB; (void)KC; (void)VC; (void)WQKT; (void)VWOT; (void)XB; (void)Q; (void)KB; (void)VT; (void)CU; (void)GB; (void)SGA; (void)SGB; (void)TMP; (void)MRG; (void)PB; (void)ACT; (void)YB; (void)OA; (void)RS1; (void)RS2; (void)RS3; (void)SCR; (void)out;
    if (ph == 0) {
    hipLaunchKernelGGL(nv_wconv_t<1>, dim3(nblk((size_t)INW * D)), dim3(256), 0, stream, w_in, D, INW, W1T, (const float*)nullptr, 1.0f);
    hipLaunchKernelGGL(nv_wconv_t<0>, dim3(nblk((size_t)D * SBW)), dim3(256), 0, stream, w_a, SBW, D, WAT, (const float*)nullptr, 1.0f);
    hipLaunchKernelGGL(nv_wconv_t<0>, dim3(nblk((size_t)D * CW)), dim3(256), 0, stream, w_b, CW, D, WBT, (const float*)nullptr, 1.0f);
    hipLaunchKernelGGL(nv_wconv_t<0>, dim3(nblk((size_t)D * D)), dim3(256), 0, stream, w_mix, D, D, WMT, (const float*)nullptr, 1.0f);
    hipLaunchKernelGGL(nv_wconv_n, dim3(nblk((size_t)D * D)), dim3(256), 0, stream, w_memq, D, D, WQ2, norm_memq, 1.0f / 16.0f);
    hipLaunchKernelGGL(nv_wconv_t<0>, dim3(nblk((size_t)D * 2048)), dim3(256), 0, stream, w_memkv, D, 2048, WKVT, (const float*)nullptr, 1.0f);
    hipLaunchKernelGGL(nv_wconv_t<0>, dim3(nblk((size_t)D * D)), dim3(256), 0, stream, w_memo, D, D, WOT, (const float*)nullptr, 1.0f);
    hipLaunchKernelGGL(nv_wconv_t<2>, dim3(nblk((size_t)D * FF2)), dim3(256), 0, stream, w_ffn_in, D, FF2, WF1T, norm_ffn, 1.0f);
    hipLaunchKernelGGL(nv_wconv_t<0>, dim3(nblk((size_t)FF * D)), dim3(256), 0, stream, w_ffn_out, FF, D, WF2T, (const float*)nullptr, 1.0f);
    hipLaunchKernelGGL(nv_rmsnorm_bf16, dim3(M), dim3(256), 0, stream, x, norm_mix, XB);
    hipLaunchKernelGGL(nv_rmsnorm_bf16, dim3(MROWS), dim3(256), 0, stream, mem, norm_memkv, MEMB);
    }
    if (ph == 1) {
    for (int t0 = 0; t0 < M; t0 += CH) {
        hipLaunchKernelGGL(nv_gemm, dim3(INW / 64, CH / 64), dim3(256), 0, stream, XB + (size_t)t0 * D, D, W1T, D, SCR, INW, D);
        hipLaunchKernelGGL(nv_epi1, dim3(nblk((size_t)CH * INW)), dim3(256), 0, stream, SCR, t0, CH, Q, KB, VT, CU, GB, SGA, SGB);
    }
    hipLaunchKernelGGL(nv_gemm, dim3(2048 / 64, MROWS / 64), dim3(256), 0, stream, MEMB, D, WKVT, D, SCR, 2048, D);
    hipLaunchKernelGGL(nv_epi_kv, dim3(nblk((size_t)MROWS * 2048)), dim3(256), 0, stream, SCR, KC, VC);
    }
    if (ph == 2) {
    hipLaunchKernelGGL(nv_sb_attn, dim3(BATCH * SBH * SEQ / 64), dim3(64), 0, stream, Q, KB, VT, OA);
    hipLaunchKernelGGL(nv_conv, dim3(nblk((size_t)M * CW)), dim3(256), 0, stream, CU, GB, conv_w, YB);
    }
    if (ph == 3) {
    for (int t0 = 0; t0 < M; t0 += CH) {
        hipLaunchKernelGGL(nv_gemm, dim3(D / 64, CH / 64), dim3(256), 0, stream, OA + (size_t)t0 * 512, 512, WAT, 512, SCR, D, 512);
        hipLaunchKernelGGL(nv_epi3a, dim3(nblk((size_t)CH * D)), dim3(256), 0, stream, SCR, t0, CH, SGA, TMP);
    }
    for (int t0 = 0; t0 < M; t0 += CH) {
        hipLaunchKernelGGL(nv_gemm, dim3(D / 64, CH / 64), dim3(256), 0, stream, YB + (size_t)t0 * 512, 512, WBT, 512, SCR, D, 512);
        hipLaunchKernelGGL(nv_epi3b, dim3(nblk((size_t)CH * D)), dim3(256), 0, stream, SCR, t0, CH, SGB, TMP, MRG);
    }
    }
    if (ph == 4) {
    for (int t0 = 0; t0 < M; t0 += CH) {
        hipLaunchKernelGGL(nv_gemm, dim3(D / 64, CH / 64), dim3(256), 0, stream, MRG + (size_t)t0 * D, D, WMT, D, SCR, D, D);
        hipLaunchKernelGGL(nv_epi_res, dim3(CH), dim3(256), 0, stream, SCR, t0, x, out, XB, RS1);
    }
    for (int b = 0; b < BATCH; ++b)
        for (int h = 0; h < MH; ++h) {
            hipLaunchKernelGGL(nv_gemm, dim3(D / 64, 256 / 64), dim3(256), 0, stream, KC + (size_t)(b * 256) * 1024 + h * 256, 1024, WQ2 + h * 256, 1024, SCR, D, 256);
            hipLaunchKernelGGL(nv_store_bf16, dim3(nblk((size_t)256 * D)), dim3(256), 0, stream, SCR, 256, D, WQKT + ((size_t)b * 1024 + h * 256) * 1024, 1024);
            hipLaunchKernelGGL(nv_gemm, dim3(256 / 64, D / 64), dim3(256), 0, stream, WOT + h * 256, 1024, VC + (size_t)(b * 256) * 1024 + h * 256, 1024, SCR, 256, 256);
            hipLaunchKernelGGL(nv_store_bf16, dim3(nblk((size_t)D * 256)), dim3(256), 0, stream, SCR, D, 256, VWOT + (size_t)b * 1024 * 1024 + h * 256, 1024);
        }
    }
    if (ph == 5) {
    for (int t0 = 0; t0 < M; t0 += CH) {
        const int b = t0 / SEQ;
        hipLaunchKernelGGL(nv_gemm, dim3(D / 64, CH / 64), dim3(256), 0, stream, XB + (size_t)t0 * D, D, WQKT + (size_t)b * 1024 * 1024, D, SCR, D, D);
        hipLaunchKernelGGL(nv_epi_softmax, dim3(nblk((size_t)CH * MH)), dim3(256), 0, stream, SCR, t0, CH, RS1, PB);
    }
    }
    if (ph == 6) {
    for (int t0 = 0; t0 < M; t0 += CH) {
        const int b = t0 / SEQ;
        hipLaunchKernelGGL(nv_gemm, dim3(D / 64, CH / 64), dim3(256), 0, stream, PB + (size_t)t0 * D, D, VWOT + (size_t)b * 1024 * 1024, D, SCR, D, D);
        hipLaunchKernelGGL(nv_epi_res, dim3(CH), dim3(256), 0, stream, SCR, t0, out, out, XB, RS2);
    }
    }
    if (ph == 7) {
    for (int t0 = 0; t0 < M; t0 += CH) {
        hipLaunchKernelGGL(nv_gemm, dim3(FF2 / 64, CH / 64), dim3(256), 0, stream, XB + (size_t)t0 * D, D, WF1T, D, SCR, FF2, D);
        hipLaunchKernelGGL(nv_epi_swiglu, dim3(nblk((size_t)CH * FF)), dim3(256), 0, stream, SCR, t0, CH, RS2, ACT);
    }
    }
    if (ph == 8) {
    for (int t0 = 0; t0 < M; t0 += CH) {
        hipLaunchKernelGGL(nv_gemm, dim3(D / 64, CH / 64), dim3(256), 0, stream, ACT + (size_t)t0 * FF, FF, WF2T, FF, SCR, D, FF);
        hipLaunchKernelGGL(nv_epi_res, dim3(CH), dim3(256), 0, stream, SCR, t0, out, out, (bf16*)nullptr, RS3);
    }
    }
    if (ph == 9) {
    hipLaunchKernelGGL(nv_final, dim3(M), dim3(256), 0, stream, out, RS3, norm_final);
    }
}
extern "C" void kernel_launch(void* const* d_in, const int* in_sizes, int n_in, void* d_out, int out_size, void* d_ws, size_t ws_size, hipStream_t stream) {
    static int ready = 0;
    if (ready == 0) {
        if (n_in != 17 || in_sizes[0] != M * D || out_size != M * D || ws_size < WS_END) { fprintf(stderr, "kernel_launch: unexpected shapes (n_in %d, in0 %d, out %d, ws %zu); nothing launched\n", n_in, n_in > 0 ? in_sizes[0] : -1, out_size, ws_size); ready = -1; return; }
        if (hipFuncSetAttribute((const void*)mega_fwd, hipFuncAttributeMaxDynamicSharedMemorySize, LDS_BYTES) != hipSuccess) { fprintf(stderr, "kernel_launch: hipFuncSetAttribute failed\n"); ready = -1; return; }
        int dev = 0, cus = 0, per_cu = 0;
        if (hipGetDevice(&dev) != hipSuccess || hipDeviceGetAttribute(&cus, hipDeviceAttributeMultiprocessorCount, dev) != hipSuccess) cus = -1;
        if (hipOccupancyMaxActiveBlocksPerMultiprocessor(&per_cu, (const void*)mega_fwd, NWAVES * 64, LDS_BYTES) != hipSuccess) per_cu = -1;
        (void)hipGetLastError();
        if (cus != 256 || per_cu < 1) fprintf(stderr, "kernel_launch: note: %d CUs, occupancy query %d workgroups per CU; this kernel launches 256 workgroups, one per CU (144 KiB LDS each)\n", cus, per_cu);
        ready = 1;
    }
    if (ready < 0) return;
    if (hipMemsetAsync((char*)d_ws + WS_CTL, 0, CTL_ZERO_BYTES, stream) != hipSuccess) { fprintf(stderr, "kernel_launch: hipMemsetAsync failed\n"); return; }
    Args a{};
    for (int i = 0; i < 17; ++i) a.in[i] = (const float*)d_in[i];
    a.out = (float*)d_out; a.ws = (unsigned char*)d_ws;
    int li = 0;
    for (int ph = 0; ph < N_PHASES;) {
        if ((MEGA_MASK >> ph) & 1) {
            int hi = ph; while (hi < N_PHASES && ((MEGA_MASK >> hi) & 1)) ++hi;
            a.ph_lo = ph; a.ph_hi = hi; a.li = li++;
            hipLaunchKernelGGL(mega_fwd, dim3(256), dim3(NWAVES * 64), LDS_BYTES, stream, a);
            const hipError_t le = hipPeekAtLastError();
            if (le != hipSuccess) { fprintf(stderr, "kernel_launch: launch of phases [%d,%d) failed: %s\n", ph, hi, hipGetErrorName(le)); return; }
            ph = hi;
        } else { naive_phase(ph, d_in, d_out, d_ws, stream); ++ph; }
    }
}
```
